# Optimizing an MI355X kernel written in HIP

```python
import jax, jax.numpy as jnp
from jax import lax
import numpy as np

D_MODEL = 1024
BATCH = 2
SEQ = 8192
DEPTH = 1

GRID_W = 64
CTX_LEN = 256
HG_HEADS = 8
HG_DK = 128
HG_DV = 128
HG_WIDTH = HG_HEADS * HG_DK
HG_CHUNK = 64
NA_HEADS = 16
NA_HD = 64
NA_WIDTH = NA_HEADS * NA_HD
NA_WIN_R = 8
NA_WIN_C = 16
NA_QCOLS = 16
NA_KCOLS = 32
ROPE_THETA = 10000.0
NEG_INF = -1e30
N_EXPERTS = 64
EXPERT_DIM = 256
TOP_K = 8
N_GROUPS = 8
TOPK_GROUPS = 4
ROUTED_SCALE = 2.5
SHARED_DIM = 256
MOE_BLOCK = 128
LN_EPS = 1e-6
IN_SPLITS = (HG_WIDTH, HG_WIDTH, HG_WIDTH, HG_WIDTH, HG_WIDTH, NA_WIDTH, NA_WIDTH, NA_WIDTH, D_MODEL, D_MODEL)
IN_WIDTH = 5 * HG_WIDTH + 3 * NA_WIDTH + 2 * D_MODEL

kernel_name = "hybrid_hgrn2_natten_moe_dit_block"


def _normalize(x):
    xf = x.astype(jnp.float32)
    mu = jnp.mean(xf, axis=-1, keepdims=True)
    var = jnp.mean(jnp.square(xf - mu), axis=-1, keepdims=True)
    return (xf - mu) * lax.rsqrt(var + LN_EPS)


def layer_norm(x, g, b):
    return (_normalize(x) * g.astype(jnp.float32) + b.astype(jnp.float32)).astype(x.dtype)


def modulate(x, shift, scale):
    return (_normalize(x) * (1.0 + scale.astype(jnp.float32)) + shift.astype(jnp.float32)).astype(x.dtype)


def split_cols(p):
    offs = np.cumsum(IN_SPLITS)[:-1].tolist()
    return jnp.split(p, offs, axis=-1)


def to_heads(t, n_heads):
    b, s, w = t.shape
    return t.reshape(b, s, n_heads, w // n_heads).transpose(0, 2, 1, 3)


def from_heads(t):
    b, h, s, d = t.shape
    return t.transpose(0, 2, 1, 3).reshape(b, s, h * d)


def gla_chunked(q, k, v, log_f, s0):
    b, h, t, dk = k.shape
    dv = v.shape[-1]
    n = t // HG_CHUNK
    ch = lambda u: u.reshape(b, h, n, HG_CHUNK, u.shape[-1])
    k, v, log_f = ch(k), ch(v), ch(log_f)
    a = jnp.cumsum(log_f, axis=3)
    a_last = a[:, :, :, -1:, :]
    u = jnp.einsum('bhnck,bhncv->nbhkv', k * jnp.exp(a_last - a), v)
    decay = jnp.moveaxis(jnp.exp(a_last[:, :, :, 0, :]), 2, 0)

    def step(s, inp):
        d, uc = inp
        return d[..., None] * s + uc, s

    s_final, s_prev = lax.scan(step, s0, (decay, u))
    if q is None:
        return None, s_final
    q = ch(q)
    qa = q * jnp.exp(a)
    kb = k * jnp.exp(-a)
    scores = jnp.einsum('bhnik,bhnjk->bhnij', qa, kb)
    causal = jnp.tril(jnp.ones((HG_CHUNK, HG_CHUNK), dtype=bool))
    scores = jnp.where(causal, scores, 0.0)
    o = jnp.einsum('bhnij,bhnjv->bhniv', scores, v) + jnp.einsum('bhnik,nbhkv->bhniv', qa, s_prev)
    return o.reshape(b, h, t, dv), s_final


def hgrn2_bidir(q, i, f_fwd, f_bwd, lb_fwd, lb_bwd, s_fwd0, s_bwd0, with_output):
    def gates(f_raw, lb):
        lb = lb[None, :, None, :]
        f = lb + (1.0 - lb) * jax.nn.sigmoid(f_raw)
        return 1.0 - f, jnp.log(f)

    rev = lambda t: jnp.flip(t, axis=2)
    k_f, lf_f = gates(f_fwd, lb_fwd)
    k_b, lf_b = gates(f_bwd, lb_bwd)
    qs = jax.nn.silu(q) if with_output else None
    o_f, s_f = gla_chunked(qs, k_f, i, lf_f, s_fwd0)
    o_b, s_b = gla_chunked(rev(qs) if with_output else None, rev(k_b), rev(i), rev(lf_b), s_bwd0)
    o = (o_f + rev(o_b)) if with_output else None
    return o, s_f, s_b


def hgrn2_readout(o, og, g):
    on = o * lax.rsqrt(jnp.mean(jnp.square(o), axis=-1, keepdims=True) + LN_EPS)
    on = from_heads(on) * g.astype(jnp.float32)
    return (on * jax.nn.silu(og.astype(jnp.float32))).astype(og.dtype)


def axial_rope(t):
    s, hd = t.shape[2], t.shape[3]
    half = hd // 2
    pos = jnp.arange(s)
    row = (pos // GRID_W).astype(jnp.float32)
    col = (pos % GRID_W).astype(jnp.float32)
    inv = jnp.power(ROPE_THETA, -jnp.arange(0, half, 2, dtype=jnp.float32) / half)

    def rot(u, p):
        ang = p[:, None] * inv[None, :]
        cos = jnp.cos(ang).astype(u.dtype)
        sin = jnp.sin(ang).astype(u.dtype)
        u1, u2 = jnp.split(u, 2, axis=-1)
        return jnp.concatenate([u1 * cos - u2 * sin, u1 * sin + u2 * cos], axis=-1)

    return jnp.concatenate([rot(t[..., :half], row), rot(t[..., half:], col)], axis=-1)


def na_indices(rows):
    wr = min(NA_WIN_R, rows)
    r = np.arange(rows)
    row_start = np.clip(r - wr // 2, 0, rows - wr)
    key_rows = row_start[:, None] + np.arange(wr)[None, :]
    ng = GRID_W // NA_QCOLS
    g = np.arange(ng)
    blk_start = np.clip(g * NA_QCOLS - NA_WIN_C // 2, 0, GRID_W - NA_KCOLS)
    key_cols = blk_start[:, None] + np.arange(NA_KCOLS)[None, :]
    qcol = g[:, None] * NA_QCOLS + np.arange(NA_QCOLS)[None, :]
    col_start = np.clip(qcol - NA_WIN_C // 2, 0, GRID_W - NA_WIN_C)
    in_win = (key_cols[:, None, :] >= col_start[:, :, None]) & (key_cols[:, None, :] < col_start[:, :, None] + NA_WIN_C)
    mask = np.broadcast_to(in_win[:, :, None, :], (ng, NA_QCOLS, wr, NA_KCOLS)).reshape(ng, NA_QCOLS, wr * NA_KCOLS)
    flat = (key_rows[:, None, :, None] * GRID_W + key_cols[None, :, None, :]).reshape(rows, ng, wr * NA_KCOLS)
    dr = key_rows - r[:, None] + (NA_WIN_R - 1)
    dc = np.clip(key_cols[:, None, :] - qcol[:, :, None] + (NA_WIN_C - 1), 0, 2 * NA_WIN_C - 2)
    return wr, ng, flat, mask, dr, dc


def neighborhood_attention(q_rot, k_rot, v, q, k_ctx, v_ctx, rpb):
    b, h, s, hd = q.shape
    rows = s // GRID_W
    wr, ng, flat, mask, dr, dc = na_indices(rows)
    nk = wr * NA_KCOLS
    idx = jnp.asarray(flat.reshape(-1))
    k_blk = jnp.take(k_rot, idx, axis=2).reshape(b, h, rows, ng, nk, hd)
    v_blk = jnp.take(v, idx, axis=2).reshape(b, h, rows, ng, nk, hd)
    qr = q_rot.reshape(b, h, rows, ng, NA_QCOLS, hd)
    qp = q.reshape(b, h, rows, ng, NA_QCOLS, hd)
    scale = NA_HD ** -0.5
    bias = rpb[:, dr[:, None, None, :, None], dc[None, :, :, None, :]]
    bias = bias.reshape(h, rows, ng, NA_QCOLS, nk).astype(jnp.float32)
    s_win = jnp.einsum('bhrgqd,bhrgkd->bhrgqk', qr, k_blk, preferred_element_type=jnp.float32) * scale + bias
    s_win = jnp.where(jnp.asarray(mask)[None, None, None], s_win, NEG_INF)
    s_ctx = jnp.einsum('bhrgqd,bhcd->bhrgqc', qp, k_ctx, preferred_element_type=jnp.float32) * scale
    p = jax.nn.softmax(jnp.concatenate([s_win, s_ctx], axis=-1), axis=-1).astype(v.dtype)
    o = (jnp.einsum('bhrgqk,bhrgkd->bhrgqd', p[..., :nk], v_blk)
         + jnp.einsum('bhrgqc,bhcd->bhrgqd', p[..., nk:], v_ctx))
    return o.reshape(b, h, s, hd)


def context_attention(q, k, v):
    s = jnp.einsum('bhqd,bhkd->bhqk', q, k, preferred_element_type=jnp.float32) * NA_HD ** -0.5
    p = jax.nn.softmax(s, axis=-1).astype(v.dtype)
    return jnp.einsum('bhqk,bhkd->bhqd', p, v)


def token_mixer(h, hc, w_in, lb_fwd, lb_bwd, hg_norm_g, rpb, w_branch_a, w_branch_b, w_out, ctx_out):
    b = h.shape[0]
    q_hg, ff, fb, i_hg, og, q_na, k_na, v_na, g_a, g_b = split_cols(h @ w_in)
    cq_hg, cff, cfb, ci_hg, cog, cq_na, ck_na, cv_na, cg_a, cg_b = split_cols(hc @ w_in)
    hh = lambda t: to_heads(t, HG_HEADS).astype(jnp.float32)
    s0 = jnp.zeros((b, HG_HEADS, HG_DK, HG_DV), jnp.float32)
    o_c, s_cf, s_cb = hgrn2_bidir(hh(cq_hg), hh(ci_hg), hh(cff), hh(cfb), lb_fwd, lb_bwd, s0, s0, ctx_out)
    o, _, _ = hgrn2_bidir(hh(q_hg), hh(i_hg), hh(ff), hh(fb), lb_fwd, lb_bwd, s_cf, s_cb, True)
    y_hg = hgrn2_readout(o, og, hg_norm_g)
    na = lambda t: to_heads(t, NA_HEADS)
    qn, kn, vn = na(q_na), na(k_na), na(v_na)
    kc, vc = na(ck_na), na(cv_na)
    y_na = from_heads(neighborhood_attention(axial_rope(qn), axial_rope(kn), vn, qn, kc, vc, rpb))
    y = (jax.nn.sigmoid(g_a) * (y_hg @ w_branch_a) + jax.nn.sigmoid(g_b) * (y_na @ w_branch_b)) @ w_out
    if not ctx_out:
        return y, None
    yc_hg = hgrn2_readout(o_c, cog, hg_norm_g)
    yc_na = from_heads(context_attention(na(cq_na), kc, vc))
    yc = (jax.nn.sigmoid(cg_a) * (yc_hg @ w_branch_a) + jax.nn.sigmoid(cg_b) * (yc_na @ w_branch_b)) @ w_out
    return y, yc


def moe_ffn(h, w_router, router_bias, w_e_gate, w_e_up, w_e_down, w_sh_gate, w_sh_up, w_sh_down):
    tok = h.reshape(-1, MOE_BLOCK, h.shape[-1])

    def block(xb):
        scores = jax.nn.sigmoid(jnp.matmul(xb, w_router, preferred_element_type=jnp.float32))
        sel = scores + router_bias.astype(jnp.float32)
        grp = sel.reshape(-1, N_GROUPS, N_EXPERTS // N_GROUPS)
        grp_score = jnp.sum(lax.top_k(grp, 2)[0], axis=-1)
        _, top_g = lax.top_k(grp_score, TOPK_GROUPS)
        gmask = jnp.sum(jax.nn.one_hot(top_g, N_GROUPS, dtype=jnp.float32), axis=1)
        emask = jnp.repeat(gmask, N_EXPERTS // N_GROUPS, axis=-1)
        sel = jnp.where(emask > 0, sel, -jnp.inf)
        _, top_e = lax.top_k(sel, TOP_K)
        w = jnp.take_along_axis(scores, top_e, axis=-1)
        w = w / jnp.sum(w, axis=-1, keepdims=True) * ROUTED_SCALE
        gates = jnp.sum(jax.nn.one_hot(top_e, N_EXPERTS, dtype=jnp.float32) * w[..., None], axis=1)
        a = jnp.einsum('td,edf->tef', xb, w_e_gate)
        u = jnp.einsum('td,edf->tef', xb, w_e_up)
        act = jax.nn.silu(a) * u * gates[..., None].astype(xb.dtype)
        routed = jnp.einsum('tef,efd->td', act, w_e_down)
        shared = (jax.nn.silu(xb @ w_sh_gate) * (xb @ w_sh_up)) @ w_sh_down
        return routed + shared

    return lax.map(block, tok).reshape(h.shape)


def setup_inputs(seed: int = 0) -> dict:
    key = jax.random.key(seed)
    ks = jax.random.split(key, 26)
    f32 = jnp.float32
    beta = (8.0 * DEPTH) ** -0.25
    nrm = lambda k, shape, s: jax.random.normal(k, shape, f32) * s
    col_scale = jnp.ones((IN_WIDTH,), f32)
    col_scale = col_scale.at[3 * HG_WIDTH:4 * HG_WIDTH].set(beta)
    col_scale = col_scale.at[5 * HG_WIDTH + 2 * NA_WIDTH:5 * HG_WIDTH + 3 * NA_WIDTH].set(beta)
    return {
        "x": nrm(ks[0], (BATCH, SEQ, D_MODEL), 1.0),
        "c": nrm(ks[1], (BATCH, D_MODEL), 1.0),
        "ctx": nrm(ks[2], (BATCH, CTX_LEN, D_MODEL), 1.0),
        "c_ctx": nrm(ks[3], (D_MODEL,), 1.0),
        "w_ada": nrm(ks[4], (DEPTH, D_MODEL, 6 * D_MODEL), 0.5 * D_MODEL ** -0.5),
        "b_ada": nrm(ks[5], (DEPTH, 6 * D_MODEL), 0.02),
        "w_in": nrm(ks[6], (DEPTH, D_MODEL, IN_WIDTH), D_MODEL ** -0.5) * col_scale,
        "hg_lb_fwd": nrm(ks[7], (DEPTH + 1, HG_WIDTH), 0.1),
        "hg_lb_bwd": nrm(ks[8], (DEPTH + 1, HG_WIDTH), 0.1),
        "hg_norm_g": 1.0 + nrm(ks[9], (DEPTH, HG_WIDTH), 0.02),
        "na_rpb": nrm(ks[10], (DEPTH, NA_HEADS, 2 * NA_WIN_R - 1, 2 * NA_WIN_C - 1), 0.02),
        "w_branch_a": nrm(ks[11], (DEPTH, HG_WIDTH, D_MODEL), HG_WIDTH ** -0.5),
        "w_branch_b": nrm(ks[12], (DEPTH, NA_WIDTH, D_MODEL), NA_WIDTH ** -0.5),
        "w_out": nrm(ks[13], (DEPTH, D_MODEL, D_MODEL), beta * D_MODEL ** -0.5),
        "ln1_g": 1.0 + nrm(ks[14], (DEPTH, D_MODEL), 0.02),
        "ln1_b": nrm(ks[15], (DEPTH, D_MODEL), 0.02),
        "w_router": nrm(ks[16], (DEPTH, D_MODEL, N_EXPERTS), D_MODEL ** -0.5),
        "router_bias": nrm(ks[17], (DEPTH, N_EXPERTS), 0.01),
        "w_e_gate": nrm(ks[18], (DEPTH, N_EXPERTS, D_MODEL, EXPERT_DIM), D_MODEL ** -0.5),
        "w_e_up": nrm(ks[19], (DEPTH, N_EXPERTS, D_MODEL, EXPERT_DIM), D_MODEL ** -0.5),
        "w_e_down": nrm(ks[20], (DEPTH, N_EXPERTS, EXPERT_DIM, D_MODEL), beta * EXPERT_DIM ** -0.5),
        "w_sh_gate": nrm(ks[21], (DEPTH, D_MODEL, SHARED_DIM), D_MODEL ** -0.5),
        "w_sh_up": nrm(ks[22], (DEPTH, D_MODEL, SHARED_DIM), D_MODEL ** -0.5),
        "w_sh_down": nrm(ks[23], (DEPTH, SHARED_DIM, D_MODEL), beta * SHARED_DIM ** -0.5),
        "ln2_g": 1.0 + nrm(ks[24], (DEPTH, D_MODEL), 0.02),
        "ln2_b": nrm(ks[25], (DEPTH, D_MODEL), 0.02),
    }


def reference(x, c, ctx, c_ctx, w_ada, b_ada, w_in, hg_lb_fwd, hg_lb_bwd, hg_norm_g, na_rpb,
              w_branch_a, w_branch_b, w_out, ln1_g, ln1_b, w_router, router_bias, w_e_gate, w_e_up,
              w_e_down, w_sh_gate, w_sh_up, w_sh_down, ln2_g, ln2_b):
    alpha = (2.0 * DEPTH) ** 0.25
    lb_fwd = jnp.cumsum(jax.nn.softmax(hg_lb_fwd.astype(jnp.float32), axis=0), axis=0)
    lb_bwd = jnp.cumsum(jax.nn.softmax(hg_lb_bwd.astype(jnp.float32), axis=0), axis=0)
    cond = jax.nn.silu(c)
    cond_ctx = jax.nn.silu(c_ctx)
    for l in range(DEPTH):
        ctx_needed = l < DEPTH - 1
        mod = (cond @ w_ada[l] + b_ada[l])[:, None, :]
        mod_c = cond_ctx @ w_ada[l] + b_ada[l]
        sh1, sc1, g1, sh2, sc2, g2 = jnp.split(mod, 6, axis=-1)
        csh1, csc1, cg1, csh2, csc2, cg2 = jnp.split(mod_c, 6, axis=-1)
        h = modulate(x, sh1, sc1)
        hc = modulate(ctx, csh1, csc1)
        y, yc = token_mixer(h, hc, w_in[l], lb_fwd[l].reshape(HG_HEADS, HG_DK),
                            lb_bwd[l].reshape(HG_HEADS, HG_DK), hg_norm_g[l], na_rpb[l],
                            w_branch_a[l], w_branch_b[l], w_out[l], ctx_needed)
        x = layer_norm(alpha * x + g1 * y, ln1_g[l], ln1_b[l])
        y2 = moe_ffn(modulate(x, sh2, sc2), w_router[l], router_bias[l], w_e_gate[l], w_e_up[l],
                     w_e_down[l], w_sh_gate[l], w_sh_up[l], w_sh_down[l])
        x = layer_norm(alpha * x + g2 * y2, ln2_g[l], ln2_b[l])
        if ctx_needed:
            ctx = layer_norm(alpha * ctx + cg1 * yc, ln1_g[l], ln1_b[l])
            yc2 = moe_ffn(modulate(ctx, csh2, csc2), w_router[l], router_bias[l], w_e_gate[l], w_e_up[l],
                          w_e_down[l], w_sh_gate[l], w_sh_up[l], w_sh_down[l])
            ctx = layer_norm(alpha * ctx + cg2 * yc2, ln2_g[l], ln2_b[l])
    return x
```

```cpp
#include <hip/hip_runtime.h>
#include <hip/hip_cooperative_groups.h>
#include <cstdio>
#include <cmath>
#include <cstdint>
namespace cg = cooperative_groups;

typedef unsigned short bf16_t;
typedef unsigned short f16_t;

constexpr int D = 1024, NB = 2, SEQ = 8192, CTX = 256;
constexpr int NTOK = NB * SEQ;
constexpr int NROW = NTOK + NB * CTX;
constexpr int PB_ROWS = SEQ + CTX;
constexpr int INW = 10240;
constexpr int NEXP = 64, EDIM = 256;
constexpr float LN_EPS = 1e-6f;
constexpr float ALPHA = 1.189207115002721f;
constexpr float ROUTED_SCALE = 2.5f;

__device__ __forceinline__ float bf2f(bf16_t v) { return __uint_as_float(((unsigned)v) << 16); }
__device__ __forceinline__ bf16_t f2bf(float f) { unsigned u = __float_as_uint(f); u += 0x7fffu + ((u >> 16) & 1u); return (bf16_t)(u >> 16); }
__device__ __forceinline__ float h2f(f16_t v) { _Float16 h; __builtin_memcpy(&h, &v, 2); return (float)h; }
__device__ __forceinline__ f16_t f2h(float f) { _Float16 h = (_Float16)f; f16_t v; __builtin_memcpy(&v, &h, 2); return v; }
__device__ __forceinline__ float sigmoidf_(float x) { return 1.0f / (1.0f + __expf(-x)); }
__device__ __forceinline__ float siluf_(float x) { return x / (1.0f + __expf(-x)); }
__device__ __forceinline__ float wave_sum(float v) {
#pragma unroll
  for (int o = 32; o >= 1; o >>= 1) v += __shfl_xor(v, o);
  return v;
}

constexpr size_t MiB = 1ull << 20;
constexpr size_t OFF_MOD = 0;
constexpr size_t OFF_LBF = OFF_MOD + 3 * 6144 * 4;
constexpr size_t OFF_LBB = OFF_LBF + 4096;
constexpr size_t OFF_ROPE = OFF_LBB + 4096;
constexpr size_t OFF_CNT = OFF_ROPE + 128 * 16 * 2 * 4;
constexpr size_t OFF_TOPE = 1 * MiB;
constexpr size_t OFF_TOPW = OFF_TOPE + NTOK * 8 * 4;
constexpr size_t OFF_TOPP = OFF_TOPW + NTOK * 8 * 4;
constexpr size_t OFF_LIST = 3 * MiB;
constexpr size_t OFF_WIN = 8 * MiB;
constexpr size_t OFF_WA = OFF_WIN + 20 * MiB;
constexpr size_t OFF_WB = OFF_WA + 2 * MiB;
constexpr size_t OFF_WOUT = OFF_WB + 2 * MiB;
constexpr size_t OFF_H = 34 * MiB;
constexpr size_t PSZ = (size_t)PB_ROWS * 1024 * 2;
constexpr size_t OFF_P = 67 * MiB;
constexpr size_t OFF_Q = OFF_P + 0 * PSZ, OFF_LF = OFF_P + 1 * PSZ, OFF_LB = OFF_P + 2 * PSZ, OFF_I = OFF_P + 3 * PSZ, OFF_OG = OFF_P + 4 * PSZ,
                 OFF_QR = OFF_P + 5 * PSZ, OFF_QN = OFF_P + 6 * PSZ, OFF_KN = OFF_P + 7 * PSZ, OFF_V = OFF_P + 8 * PSZ;
constexpr size_t OFF_E = OFF_P + 9 * PSZ;
constexpr size_t OFF_GA = OFF_P;
constexpr size_t OFF_GB = OFF_P + 32 * MiB;
constexpr size_t OFF_T1 = OFF_P + 64 * MiB;
constexpr size_t OFF_T = OFF_P + 128 * MiB;
constexpr size_t OFF_WGU = 230 * MiB;
constexpr size_t OFF_WD = 295 * MiB;
constexpr size_t OFF_H2 = OFF_H;
constexpr size_t OFF_Y2 = OFF_P;

__device__ __forceinline__ void transpose_tile32(const float* __restrict__ src, int src_ld, bf16_t* __restrict__ dst, int dst_ld, float (*t)[33]) {
  const int tx = threadIdx.x & 31, ty = threadIdx.x >> 5;
#pragma unroll
  for (int i = 0; i < 4; ++i) t[ty + 8 * i][tx] = src[(size_t)(ty + 8 * i) * src_ld + tx];
  __syncthreads();
#pragma unroll
  for (int i = 0; i < 4; ++i) dst[(size_t)(ty + 8 * i) * dst_ld + tx] = f2bf(t[tx][ty + 8 * i]);
  __syncthreads();
}
__global__ void __launch_bounds__(256) k_transpose(const float* __restrict__ W, bf16_t* __restrict__ Wt, int K, int N) {
  __shared__ float t[32][33];
  const int tn = N / 32, tk = K / 32;
  for (int tile = blockIdx.x; tile < tn * tk; tile += gridDim.x) {
    const int kn = tile % tn, kk = tile / tn;
    transpose_tile32(W + (size_t)kk * 32 * N + kn * 32, N, Wt + (size_t)kn * 32 * K + kk * 32, K, t);
  }
}
__global__ void __launch_bounds__(256) k_conv_gu(const float* __restrict__ weg, const float* __restrict__ weu, const float* __restrict__ wsg, const float* __restrict__ wsu, bf16_t* __restrict__ WGU) {
  __shared__ float t[32][33];
  for (int tile = blockIdx.x; tile < 65 * 16 * 32; tile += gridDim.x) {
    const int kk = tile & 31, rt = (tile >> 5) & 15, e = tile >> 9;
    const int r0 = rt * 32, pn = r0 >> 8, bj = (r0 >> 7) & 1, c0 = r0 & 127, f0 = pn * 128 + c0;
    const float* src = (e < 64) ? ((bj ? weu : weg) + (size_t)e * 1024 * 256) : (bj ? wsu : wsg);
    transpose_tile32(src + (size_t)kk * 32 * 256 + f0, 256, WGU + ((size_t)e * 512 + r0) * 1024 + kk * 32, 1024, t);
  }
}
__global__ void __launch_bounds__(256) k_conv_d(const float* __restrict__ wed, const float* __restrict__ wsd, bf16_t* __restrict__ WD) {
  __shared__ float t[32][33];
  for (int tile = blockIdx.x; tile < 65 * 32 * 8; tile += gridDim.x) {
    const int ft = tile & 7, nt = (tile >> 3) & 31, e = tile >> 8;
    const float* src = (e < 64) ? (wed + (size_t)e * 256 * 1024) : wsd;
    transpose_tile32(src + (size_t)ft * 32 * 1024 + nt * 32, 1024, WD + ((size_t)e * 1024 + nt * 32) * 256 + ft * 32, 256, t);
  }
}
__global__ void __launch_bounds__(256) k_prep_small(const float* __restrict__ c, const float* __restrict__ c_ctx, const float* __restrict__ w_ada, const float* __restrict__ b_ada,
                                                    const float* __restrict__ lbf_in, const float* __restrict__ lbb_in, float* mod, float* lbf, float* lbb, float* rope, int* cnt) {
  const int gtid = blockIdx.x * 256 + threadIdx.x, gsz = gridDim.x * 256;
  for (int j = gtid; j < 6144; j += gsz) {
    float a0 = 0.f, a1 = 0.f, a2 = 0.f;
    for (int k = 0; k < 1024; ++k) {
      const float w = w_ada[(size_t)k * 6144 + j];
      a0 += siluf_(c[k]) * w; a1 += siluf_(c[1024 + k]) * w; a2 += siluf_(c_ctx[k]) * w;
    }
    const float bb = b_ada[j];
    mod[j] = a0 + bb; mod[6144 + j] = a1 + bb; mod[2 * 6144 + j] = a2 + bb;
  }
  for (int j = gtid; j < 1024; j += gsz) {
    { const float x0 = lbf_in[j], x1 = lbf_in[1024 + j], m = fmaxf(x0, x1); const float e0 = expf(x0 - m), e1 = expf(x1 - m); lbf[j] = e0 / (e0 + e1); }
    { const float x0 = lbb_in[j], x1 = lbb_in[1024 + j], m = fmaxf(x0, x1); const float e0 = expf(x0 - m), e1 = expf(x1 - m); lbb[j] = e0 / (e0 + e1); }
  }
  for (int j = gtid; j < 128 * 16; j += gsz) {
    const int p = j >> 4, i = j & 15;
    const float inv = powf(10000.0f, -(float)(2 * i) / 32.0f);
    const float ang = (float)p * inv;
    rope[2 * j] = cosf(ang); rope[2 * j + 1] = sinf(ang);
  }
  for (int j = gtid; j < 256; j += gsz) cnt[j] = 0;
}

__global__ void __launch_bounds__(256) k_ln_mod(const float* __restrict__ x, const float* __restrict__ ctx, const float* __restrict__ mod, bf16_t* __restrict__ H) {
  const int lane = threadIdx.x & 63, wid = threadIdx.x >> 6;
  for (int row = blockIdx.x * 4 + wid; row < NROW; row += gridDim.x * 4) {
    const float* src = row < NTOK ? x + (size_t)row * D : ctx + (size_t)(row - NTOK) * D;
    const int mr = row < NTOK ? (row >> 13) : 2;
    const float* sh = mod + mr * 6144, *sc = sh + 1024;
    float4 v[4]; float s = 0.f;
#pragma unroll
    for (int j = 0; j < 4; ++j) { v[j] = *(const float4*)(src + j * 256 + lane * 4); s += v[j].x + v[j].y + v[j].z + v[j].w; }
    const float mu = wave_sum(s) * (1.0f / D);
    float q = 0.f;
#pragma unroll
    for (int j = 0; j < 4; ++j) { v[j].x -= mu; v[j].y -= mu; v[j].z -= mu; v[j].w -= mu; q += v[j].x * v[j].x + v[j].y * v[j].y + v[j].z * v[j].z + v[j].w * v[j].w; }
    const float rstd = rsqrtf(wave_sum(q) * (1.0f / D) + LN_EPS);
#pragma unroll
    for (int j = 0; j < 4; ++j) {
      const int k = j * 256 + lane * 4;
      const float4 a = *(const float4*)(sc + k), b = *(const float4*)(sh + k);
      ushort4 o;
      o.x = f2bf(v[j].x * rstd * (1.f + a.x) + b.x); o.y = f2bf(v[j].y * rstd * (1.f + a.y) + b.y);
      o.z = f2bf(v[j].z * rstd * (1.f + a.z) + b.z); o.w = f2bf(v[j].w * rstd * (1.f + a.w) + b.w);
      *(ushort4*)(H + (size_t)row * D + k) = o;
    }
  }
}

template <class Epi>
__global__ void __launch_bounds__(256) k_gemm_naive(const bf16_t* __restrict__ A, const bf16_t* __restrict__ Bt, int M, int N, int K, Epi epi) {
  __shared__ float As[32][65], Bs[32][65];
  const int tx = threadIdx.x & 15, ty = threadIdx.x >> 4;
  const int m0 = blockIdx.y * 64, n0 = blockIdx.x * 64;
  float acc[4][4];
#pragma unroll
  for (int i = 0; i < 4; ++i)
#pragma unroll
    for (int j = 0; j < 4; ++j) acc[i][j] = 0.f;
  const int r = threadIdx.x >> 2, ks = (threadIdx.x & 3) * 8;
  for (int k0 = 0; k0 < K; k0 += 32) {
    const uint4 av = *(const uint4*)(A + (size_t)(m0 + r) * K + k0 + ks);
    const uint4 bv = *(const uint4*)(Bt + (size_t)(n0 + r) * K + k0 + ks);
    const unsigned aw[4] = {av.x, av.y, av.z, av.w}, bw[4] = {bv.x, bv.y, bv.z, bv.w};
#pragma unroll
    for (int j = 0; j < 4; ++j) {
      As[ks + 2 * j][r] = __uint_as_float(aw[j] << 16); As[ks + 2 * j + 1][r] = __uint_as_float(aw[j] & 0xffff0000u);
      Bs[ks + 2 * j][r] = __uint_as_float(bw[j] << 16); Bs[ks + 2 * j + 1][r] = __uint_as_float(bw[j] & 0xffff0000u);
    }
    __syncthreads();
#pragma unroll 8
    for (int kk = 0; kk < 32; ++kk) {
      float a[4], b[4];
#pragma unroll
      for (int i = 0; i < 4; ++i) { a[i] = As[kk][ty + 16 * i]; b[i] = Bs[kk][tx + 16 * i]; }
#pragma unroll
      for (int i = 0; i < 4; ++i)
#pragma unroll
        for (int j = 0; j < 4; ++j) acc[i][j] += a[i] * b[j];
    }
    __syncthreads();
  }
#pragma unroll
  for (int i = 0; i < 4; ++i) epi(m0 + ty + 16 * i, n0, tx, acc[i]);
}

struct EpiS2 {
  bf16_t *Q, *I, *OG, *QR, *QN, *KN, *V; f16_t *LF, *LB; const float *lbf, *lbb, *rope; int row_off; int is_ctx;
  __device__ void operator()(int row, int n0, int tx, const float* v) const {
    const int rb = row + row_off, cb = n0 >> 10;
    const size_t ob = (size_t)rb * 1024 + (n0 & 1023) + tx;
    if (cb == 0) { for (int j = 0; j < 4; ++j) Q[ob + 16 * j] = f2bf(siluf_(v[j])); }
    else if (cb == 1 || cb == 2) {
      const float* lb = cb == 1 ? lbf : lbb; f16_t* dst = cb == 1 ? LF : LB;
      for (int j = 0; j < 4; ++j) { const float l = lb[(n0 & 1023) + tx + 16 * j]; dst[ob + 16 * j] = f2h(logf(l + (1.f - l) * sigmoidf_(v[j]))); }
    }
    else if (cb == 3) { for (int j = 0; j < 4; ++j) I[ob + 16 * j] = f2bf(v[j]); }
    else if (cb == 4) { for (int j = 0; j < 4; ++j) OG[ob + 16 * j] = f2bf(siluf_(v[j])); }
    else if (cb == 5 || cb == 6) {
      float r[4] = {v[0], v[1], v[2], v[3]};
      if (!is_ctx) {
        const int s = row, pr = s >> 6, pc = s & 63;
        const float c0 = rope[(pr * 16 + tx) * 2], s0 = rope[(pr * 16 + tx) * 2 + 1], c1 = rope[(pc * 16 + tx) * 2], s1 = rope[(pc * 16 + tx) * 2 + 1];
        r[0] = v[0] * c0 - v[1] * s0; r[1] = v[0] * s0 + v[1] * c0; r[2] = v[2] * c1 - v[3] * s1; r[3] = v[2] * s1 + v[3] * c1;
      }
      if (cb == 5) { for (int j = 0; j < 4; ++j) { QN[ob + 16 * j] = f2bf(v[j] * 0.125f); QR[ob + 16 * j] = f2bf(r[j] * 0.125f); } }
      else { for (int j = 0; j < 4; ++j) KN[ob + 16 * j] = f2bf(r[j]); }
    }
    else if (cb == 7) { for (int j = 0; j < 4; ++j) V[ob + 16 * j] = f2bf(v[j]); }
  }
};
struct EpiSigmoid { bf16_t* O; __device__ void operator()(int row, int n0, int tx, const float* v) const { for (int j = 0; j < 4; ++j) O[(size_t)row * 1024 + n0 + tx + 16 * j] = f2bf(sigmoidf_(v[j])); } };
struct EpiT1 { const bf16_t* G; float* T1; __device__ void operator()(int row, int n0, int tx, const float* v) const { for (int j = 0; j < 4; ++j) { const size_t o = (size_t)row * 1024 + n0 + tx + 16 * j; T1[o] = bf2f(G[o]) * v[j]; } } };
struct EpiT2 { const bf16_t* G; const float* T1; bf16_t* T; __device__ void operator()(int row, int n0, int tx, const float* v) const { for (int j = 0; j < 4; ++j) { const size_t o = (size_t)row * 1024 + n0 + tx + 16 * j; T[o] = f2bf(T1[o] + bf2f(G[o]) * v[j]); } } };
struct EpiR1 { const float* x; const float* mod; float* R1; __device__ void operator()(int row, int n0, int tx, const float* v) const {
    const float* g1 = mod + (row >> 13) * 6144 + 2048;
    for (int j = 0; j < 4; ++j) { const int col = n0 + tx + 16 * j; const size_t o = (size_t)row * 1024 + col; R1[o] = ALPHA * x[o] + g1[col] * v[j]; } } };

__global__ void __launch_bounds__(128) k_hg_naive(const bf16_t* __restrict__ Q, const f16_t* __restrict__ LF, const f16_t* __restrict__ LB, const bf16_t* __restrict__ I, float* __restrict__ Of, float* __restrict__ Ob) {
  __shared__ float sf[16][128], sk[16][128], sq[16][128];
  const int h = blockIdx.x, dir = blockIdx.y, v = threadIdx.x;
  const f16_t* LG = dir ? LB : LF; float* O = dir ? Ob : Of;
  float S[128];
#pragma unroll
  for (int k = 0; k < 128; ++k) S[k] = 0.f;
  for (int t0 = 0; t0 < CTX + SEQ; t0 += 16) {
    for (int j = 0; j < 16; ++j) {
      const int t = t0 + j;
      const int rb = t < CTX ? (SEQ + (dir ? CTX - 1 - t : t)) : (dir ? SEQ - 1 - (t - CTX) : (t - CTX));
      const float f = __expf(h2f(LG[(size_t)rb * 1024 + h * 128 + v]));
      sf[j][v] = f; sk[j][v] = 1.f - f; sq[j][v] = bf2f(Q[(size_t)rb * 1024 + h * 128 + v]);
    }
    __syncthreads();
    for (int j = 0; j < 16; ++j) {
      const int t = t0 + j;
      const int rb = t < CTX ? (SEQ + (dir ? CTX - 1 - t : t)) : (dir ? SEQ - 1 - (t - CTX) : (t - CTX));
      const float vv = bf2f(I[(size_t)rb * 1024 + h * 128 + v]);
      float o = 0.f;
#pragma unroll
      for (int k = 0; k < 128; ++k) { S[k] = sf[j][k] * S[k] + sk[j][k] * vv; o += S[k] * sq[j][k]; }
      if (t >= CTX) O[(size_t)rb * 1024 + h * 128 + v] = o;
    }
    __syncthreads();
  }
}
__global__ void __launch_bounds__(256) k_hg_readout(const float* __restrict__ Of, const float* __restrict__ Ob, const bf16_t* __restrict__ OG, const float* __restrict__ g, bf16_t* __restrict__ YH  ) {
  const int lane = threadIdx.x & 63, wid = threadIdx.x >> 6;
  for (int u = blockIdx.x * 4 + wid; u < SEQ * 8; u += gridDim.x * 4) {
    const int s = u >> 3, h = u & 7; const size_t o = (size_t)s * 1024 + h * 128 + lane * 2;
    const float a = Of[o] + Ob[o], b = Of[o + 1] + Ob[o + 1];
    const float ms = wave_sum(a * a + b * b) * (1.0f / 128.0f);
    const float r = rsqrtf(ms + LN_EPS);
    YH[o] = f2bf(a * r * g[h * 128 + lane * 2] * bf2f(OG[o])); YH[o + 1] = f2bf(b * r * g[h * 128 + lane * 2 + 1] * bf2f(OG[o + 1]));
  }
}

__global__ void __launch_bounds__(256) k_na_naive(const bf16_t* __restrict__ QR, const bf16_t* __restrict__ QN, const bf16_t* __restrict__ KN, const bf16_t* __restrict__ V, const float* __restrict__ rpb, bf16_t* __restrict__ YN) {
  const int idx = blockIdx.x * 256 + threadIdx.x; const int hn = idx >> 13, s = idx & 8191;
  const int r = s >> 6, c = s & 63;
  float qr[64], o[64];
  const size_t qo = (size_t)s * 1024 + hn * 64;
#pragma unroll
  for (int d = 0; d < 64; ++d) { qr[d] = bf2f(QR[qo + d]); o[d] = 0.f; }
  float m = -3.0e38f, l = 0.f;
  const int row_start = min(max(r - 4, 0), 120), g = c >> 4, blk_start = min(max(16 * g - 8, 0), 32), col_start = min(max(c - 8, 0), 48);
  for (int kr = 0; kr < 8; ++kr)
    for (int kc = 0; kc < 32; ++kc) {
      const int krow = row_start + kr, kcol = blk_start + kc;
      if (kcol < col_start || kcol >= col_start + 16) continue;
      const size_t ko = (size_t)(krow * 64 + kcol) * 1024 + hn * 64;
      float sc = 0.f;
#pragma unroll
      for (int d = 0; d < 64; ++d) sc += qr[d] * bf2f(KN[ko + d]);
      const int dr = krow - r + 7, dc = min(max(kcol - c + 15, 0), 30);
      sc += rpb[(hn * 15 + dr) * 31 + dc];
      if (sc > m) { const float f = __expf(m - sc); l *= f;
#pragma unroll
        for (int d = 0; d < 64; ++d) o[d] *= f;
        m = sc; }
      const float p = __expf(sc - m); l += p;
#pragma unroll
      for (int d = 0; d < 64; ++d) o[d] += p * bf2f(V[ko + d]);
    }
#pragma unroll
  for (int d = 0; d < 64; ++d) qr[d] = bf2f(QN[qo + d]);
  for (int j = 0; j < CTX; ++j) {
    const size_t ko = (size_t)(SEQ + j) * 1024 + hn * 64;
    float sc = 0.f;
#pragma unroll
    for (int d = 0; d < 64; ++d) sc += qr[d] * bf2f(KN[ko + d]);
    if (sc > m) { const float f = __expf(m - sc); l *= f;
#pragma unroll
      for (int d = 0; d < 64; ++d) o[d] *= f;
      m = sc; }
    const float p = __expf(sc - m); l += p;
#pragma unroll
    for (int d = 0; d < 64; ++d) o[d] += p * bf2f(V[ko + d]);
  }
  const float il = 1.0f / l;
#pragma unroll
  for (int d = 0; d < 64; ++d) YN[qo + d] = f2bf(o[d] * il);
}

__global__ void __launch_bounds__(256) k_ln1_router(float* __restrict__ X1  , const float* __restrict__ ln_g, const float* __restrict__ ln_b, const float* __restrict__ mod,
                                                    const float* __restrict__ w_router, const float* __restrict__ rbias, bf16_t* __restrict__ H2, int* __restrict__ TOPE, float* __restrict__ TOPW) {
  const int lane = threadIdx.x & 63, wid = threadIdx.x >> 6;
  for (int row = blockIdx.x * 4 + wid; row < NTOK; row += gridDim.x * 4) {
    float* xr = X1 + (size_t)row * D;
    const float* sh = mod + (row >> 13) * 6144 + 3 * 1024, *sc = sh + 1024;
    float vals[16]; float s = 0.f;
#pragma unroll
    for (int j = 0; j < 4; ++j) { const float4 t = *(const float4*)(xr + j * 256 + lane * 4); vals[4 * j] = t.x; vals[4 * j + 1] = t.y; vals[4 * j + 2] = t.z; vals[4 * j + 3] = t.w; s += t.x + t.y + t.z + t.w; }
    float mu = wave_sum(s) * (1.0f / D), q = 0.f;
#pragma unroll
    for (int i = 0; i < 16; ++i) { vals[i] -= mu; q += vals[i] * vals[i]; }
    float rstd = rsqrtf(wave_sum(q) * (1.0f / D) + LN_EPS);
    s = 0.f;
#pragma unroll
    for (int j = 0; j < 4; ++j) {
      const int k = j * 256 + lane * 4;
      const float4 g = *(const float4*)(ln_g + k), b = *(const float4*)(ln_b + k);
      vals[4 * j] = vals[4 * j] * rstd * g.x + b.x; vals[4 * j + 1] = vals[4 * j + 1] * rstd * g.y + b.y; vals[4 * j + 2] = vals[4 * j + 2] * rstd * g.z + b.z; vals[4 * j + 3] = vals[4 * j + 3] * rstd * g.w + b.w;
      *(float4*)(xr + k) = make_float4(vals[4 * j], vals[4 * j + 1], vals[4 * j + 2], vals[4 * j + 3]);
      s += vals[4 * j] + vals[4 * j + 1] + vals[4 * j + 2] + vals[4 * j + 3];
    }
    mu = wave_sum(s) * (1.0f / D); q = 0.f;
#pragma unroll
    for (int i = 0; i < 16; ++i) { vals[i] -= mu; q += vals[i] * vals[i]; }
    rstd = rsqrtf(wave_sum(q) * (1.0f / D) + LN_EPS);
#pragma unroll
    for (int j = 0; j < 4; ++j) {
      const int k = j * 256 + lane * 4;
      const float4 a = *(const float4*)(sc + k), b = *(const float4*)(sh + k);
      vals[4 * j] = vals[4 * j] * rstd * (1.f + a.x) + b.x; vals[4 * j + 1] = vals[4 * j + 1] * rstd * (1.f + a.y) + b.y; vals[4 * j + 2] = vals[4 * j + 2] * rstd * (1.f + a.z) + b.z; vals[4 * j + 3] = vals[4 * j + 3] * rstd * (1.f + a.w) + b.w;
      ushort4 o; o.x = f2bf(vals[4 * j]); o.y = f2bf(vals[4 * j + 1]); o.z = f2bf(vals[4 * j + 2]); o.w = f2bf(vals[4 * j + 3]);
      *(ushort4*)(H2 + (size_t)row * D + k) = o;
    }
    float logit = 0.f;
#pragma unroll
    for (int j = 0; j < 4; ++j)
      for (int l = 0; l < 64; ++l)
#pragma unroll
        for (int i = 0; i < 4; ++i) { const float hv = __shfl(vals[4 * j + i], l); logit += hv * w_router[(size_t)(j * 256 + l * 4 + i) * 64 + lane]; }
    const float score = sigmoidf_(logit), sel = score + rbias[lane];
    float m1 = sel;
    m1 = fmaxf(m1, __shfl_xor(m1, 1)); m1 = fmaxf(m1, __shfl_xor(m1, 2)); m1 = fmaxf(m1, __shfl_xor(m1, 4));
    const unsigned long long bal = __ballot(sel == m1), gm = 0xFFull << (8 * (lane >> 3));
    const int first = __ffsll((unsigned long long)(bal & gm)) - 1;
    float m2 = (lane == first) ? -INFINITY : sel;
    m2 = fmaxf(m2, __shfl_xor(m2, 1)); m2 = fmaxf(m2, __shfl_xor(m2, 2)); m2 = fmaxf(m2, __shfl_xor(m2, 4));
    const float gscore = m1 + m2; const int g = lane >> 3;
    int rank_g = 0;
#pragma unroll
    for (int gg = 0; gg < 8; ++gg) { const float gs = __shfl(gscore, gg * 8); rank_g += (gs > gscore) || (gs == gscore && gg < g); }
    const bool gsel = rank_g < 4;
    const float msel = gsel ? sel : -INFINITY;
    int rank_e = 0;
    for (int e = 0; e < 64; ++e) { const float v = __shfl(msel, e); rank_e += (v > msel) || (v == msel && e < lane); }
    const bool chosen = gsel && rank_e < 8;
    const float w = chosen ? score : 0.f;
    const float wsum = wave_sum(w);
    if (chosen) { TOPE[row * 8 + rank_e] = lane; TOPW[row * 8 + rank_e] = w / wsum * ROUTED_SCALE; }
  }
}

__global__ void __launch_bounds__(256) k_moe_naive(const bf16_t* __restrict__ H2, const bf16_t* __restrict__ WGU, const bf16_t* __restrict__ WD, const int* __restrict__ TOPE, const float* __restrict__ TOPW, bf16_t* __restrict__ Y2) {
  __shared__ float hs[1024], act[256];
  const int t = blockIdx.x, tid = threadIdx.x;
  for (int k = tid; k < 1024; k += 256) hs[k] = bf2f(H2[(size_t)t * 1024 + k]);
  __syncthreads();
  float y[4] = {0.f, 0.f, 0.f, 0.f};
  for (int slot = 0; slot < 9; ++slot) {
    const int e = slot < 8 ? TOPE[t * 8 + slot] : 64; const float w = slot < 8 ? TOPW[t * 8 + slot] : 1.0f;
    const bf16_t* wg = WGU + ((size_t)e * 512 + (tid >> 7) * 256 + (tid & 127)) * 1024, *wu = wg + 128 * 1024;
    float a = 0.f, u = 0.f;
    for (int k = 0; k < 1024; k += 8) {
      const uint4 gv = *(const uint4*)(wg + k), uv = *(const uint4*)(wu + k);
      const unsigned gw[4] = {gv.x, gv.y, gv.z, gv.w}, uw[4] = {uv.x, uv.y, uv.z, uv.w};
#pragma unroll
      for (int j = 0; j < 4; ++j) {
        a += hs[k + 2 * j] * __uint_as_float(gw[j] << 16) + hs[k + 2 * j + 1] * __uint_as_float(gw[j] & 0xffff0000u);
        u += hs[k + 2 * j] * __uint_as_float(uw[j] << 16) + hs[k + 2 * j + 1] * __uint_as_float(uw[j] & 0xffff0000u);
      }
    }
    act[tid] = bf2f(f2bf(siluf_(a) * u * w));
    __syncthreads();
#pragma unroll
    for (int j = 0; j < 4; ++j) {
      const bf16_t* wd = WD + ((size_t)e * 1024 + tid + 256 * j) * 256; float acc = 0.f;
      for (int f = 0; f < 256; f += 8) {
        const uint4 dv = *(const uint4*)(wd + f); const unsigned dw[4] = {dv.x, dv.y, dv.z, dv.w};
#pragma unroll
        for (int i = 0; i < 4; ++i) acc += act[f + 2 * i] * __uint_as_float(dw[i] << 16) + act[f + 2 * i + 1] * __uint_as_float(dw[i] & 0xffff0000u);
      }
      y[j] += acc;
    }
    __syncthreads();
  }
#pragma unroll
  for (int j = 0; j < 4; ++j) Y2[(size_t)t * 1024 + tid + 256 * j] = f2bf(y[j]);
}

__global__ void __launch_bounds__(256) k_final(float* __restrict__ OUT  , const bf16_t* __restrict__ Y2, const float* __restrict__ mod, const float* __restrict__ ln_g, const float* __restrict__ ln_b) {
  const int lane = threadIdx.x & 63, wid = threadIdx.x >> 6;
  for (int row = blockIdx.x * 4 + wid; row < NTOK; row += gridDim.x * 4) {
    float* xr = OUT + (size_t)row * D; const float* g2 = mod + (row >> 13) * 6144 + 5 * 1024;
    float vals[16]; float s = 0.f;
#pragma unroll
    for (int j = 0; j < 4; ++j) {
      const int k = j * 256 + lane * 4;
      const float4 t = *(const float4*)(xr + k), gg = *(const float4*)(g2 + k); const ushort4 yv = *(const ushort4*)(Y2 + (size_t)row * D + k);
      vals[4 * j] = ALPHA * t.x + gg.x * bf2f(yv.x); vals[4 * j + 1] = ALPHA * t.y + gg.y * bf2f(yv.y); vals[4 * j + 2] = ALPHA * t.z + gg.z * bf2f(yv.z); vals[4 * j + 3] = ALPHA * t.w + gg.w * bf2f(yv.w);
      s += vals[4 * j] + vals[4 * j + 1] + vals[4 * j + 2] + vals[4 * j + 3];
    }
    const float mu = wave_sum(s) * (1.0f / D); float q = 0.f;
#pragma unroll
    for (int i = 0; i < 16; ++i) { vals[i] -= mu; q += vals[i] * vals[i]; }
    const float rstd = rsqrtf(wave_sum(q) * (1.0f / D) + LN_EPS);
#pragma unroll
    for (int j = 0; j < 4; ++j) {
      const int k = j * 256 + lane * 4;
      const float4 g = *(const float4*)(ln_g + k), b = *(const float4*)(ln_b + k);
      *(float4*)(xr + k) = make_float4(vals[4 * j] * rstd * g.x + b.x, vals[4 * j + 1] * rstd * g.y + b.y, vals[4 * j + 2] * rstd * g.z + b.z, vals[4 * j + 3] * rstd * g.w + b.w);
    }
  }
}

extern "C" void kernel_launch(void* const* d_in, const int* in_sizes, int n_in, void* d_out, int out_size, void* d_ws, size_t ws_size, hipStream_t stream) {
  const float* x = (const float*)d_in[0]; const float* c = (const float*)d_in[1]; const float* ctx = (const float*)d_in[2]; const float* c_ctx = (const float*)d_in[3];
  const float* w_ada = (const float*)d_in[4]; const float* b_ada = (const float*)d_in[5]; const float* w_in = (const float*)d_in[6];
  const float* lbf_in = (const float*)d_in[7]; const float* lbb_in = (const float*)d_in[8]; const float* hg_norm_g = (const float*)d_in[9]; const float* rpb = (const float*)d_in[10];
  const float* w_a = (const float*)d_in[11]; const float* w_b = (const float*)d_in[12]; const float* w_out = (const float*)d_in[13];
  const float* ln1_g = (const float*)d_in[14]; const float* ln1_b = (const float*)d_in[15]; const float* w_router = (const float*)d_in[16]; const float* rbias = (const float*)d_in[17];
  const float* weg = (const float*)d_in[18]; const float* weu = (const float*)d_in[19]; const float* wed = (const float*)d_in[20];
  const float* wsg = (const float*)d_in[21]; const float* wsu = (const float*)d_in[22]; const float* wsd = (const float*)d_in[23];
  const float* ln2_g = (const float*)d_in[24]; const float* ln2_b = (const float*)d_in[25];
  char* ws = (char*)d_ws; float* out = (float*)d_out;
  float* MOD = (float*)(ws + OFF_MOD); float* LBF = (float*)(ws + OFF_LBF); float* LBB = (float*)(ws + OFF_LBB); float* ROPE = (float*)(ws + OFF_ROPE); int* CNT = (int*)(ws + OFF_CNT);
  int* TOPE = (int*)(ws + OFF_TOPE); float* TOPW = (float*)(ws + OFF_TOPW);
  bf16_t* WIN = (bf16_t*)(ws + OFF_WIN); bf16_t* WA = (bf16_t*)(ws + OFF_WA); bf16_t* WB = (bf16_t*)(ws + OFF_WB); bf16_t* WOUT = (bf16_t*)(ws + OFF_WOUT);
  bf16_t* H = (bf16_t*)(ws + OFF_H);
  bf16_t* Q = (bf16_t*)(ws + OFF_Q); f16_t* LF = (f16_t*)(ws + OFF_LF); f16_t* LB = (f16_t*)(ws + OFF_LB); bf16_t* I = (bf16_t*)(ws + OFF_I); bf16_t* OG = (bf16_t*)(ws + OFF_OG);
  bf16_t* QR = (bf16_t*)(ws + OFF_QR); bf16_t* QN = (bf16_t*)(ws + OFF_QN); bf16_t* KN = (bf16_t*)(ws + OFF_KN); bf16_t* V = (bf16_t*)(ws + OFF_V);
  float* Of = (float*)(ws + OFF_E); float* Ob = Of + (size_t)SEQ * 1024;
  bf16_t* YH = (bf16_t*)d_out; bf16_t* YN = YH + (size_t)NTOK * 1024;
  bf16_t* GA = (bf16_t*)(ws + OFF_GA); bf16_t* GB = (bf16_t*)(ws + OFF_GB); float* T1 = (float*)(ws + OFF_T1); bf16_t* T = (bf16_t*)(ws + OFF_T);
  bf16_t* WGU = (bf16_t*)(ws + OFF_WGU); bf16_t* WD = (bf16_t*)(ws + OFF_WD); bf16_t* H2 = (bf16_t*)(ws + OFF_H2); bf16_t* Y2 = (bf16_t*)(ws + OFF_Y2);

  k_prep_small<<<24, 256, 0, stream>>>(c, c_ctx, w_ada, b_ada, lbf_in, lbb_in, MOD, LBF, LBB, ROPE, CNT);
  k_transpose<<<2048, 256, 0, stream>>>(w_in, WIN, 1024, INW);
  k_transpose<<<1024, 256, 0, stream>>>(w_a, WA, 1024, 1024);
  k_transpose<<<1024, 256, 0, stream>>>(w_b, WB, 1024, 1024);
  k_transpose<<<1024, 256, 0, stream>>>(w_out, WOUT, 1024, 1024);
  k_ln_mod<<<2048, 256, 0, stream>>>(x, ctx, MOD, H);
  for (int b = 0; b < NB; ++b) {
    EpiS2 e{Q, I, OG, QR, QN, KN, V, LF, LB, LBF, LBB, ROPE, 0, 0};
    k_gemm_naive<EpiS2><<<dim3(8192 / 64, SEQ / 64), 256, 0, stream>>>(H + (size_t)b * SEQ * 1024, WIN, SEQ, 8192, 1024, e);
    e.row_off = SEQ; e.is_ctx = 1;
    k_gemm_naive<EpiS2><<<dim3(8192 / 64, CTX / 64), 256, 0, stream>>>(H + (size_t)(NTOK + b * CTX) * 1024, WIN, CTX, 8192, 1024, e);
    k_hg_naive<<<dim3(8, 2), 128, 0, stream>>>(Q, LF, LB, I, Of, Ob);
    k_hg_readout<<<2048, 256, 0, stream>>>(Of, Ob, OG, hg_norm_g, YH + (size_t)b * SEQ * 1024);
    k_na_naive<<<16 * SEQ / 256, 256, 0, stream>>>(QR, QN, KN, V, rpb, YN + (size_t)b * SEQ * 1024);
  }
  k_conv_gu<<<4096, 256, 0, stream>>>(weg, weu, wsg, wsu, WGU);
  k_conv_d<<<4096, 256, 0, stream>>>(wed, wsd, WD);
  k_gemm_naive<EpiSigmoid><<<dim3(16, NTOK / 64), 256, 0, stream>>>(H, WIN + (size_t)8192 * 1024, NTOK, 1024, 1024, EpiSigmoid{GA});
  k_gemm_naive<EpiSigmoid><<<dim3(16, NTOK / 64), 256, 0, stream>>>(H, WIN + (size_t)9216 * 1024, NTOK, 1024, 1024, EpiSigmoid{GB});
  k_gemm_naive<EpiT1><<<dim3(16, NTOK / 64), 256, 0, stream>>>(YH, WA, NTOK, 1024, 1024, EpiT1{GA, T1});
  k_gemm_naive<EpiT2><<<dim3(16, NTOK / 64), 256, 0, stream>>>(YN, WB, NTOK, 1024, 1024, EpiT2{GB, T1, T});
  k_gemm_naive<EpiR1><<<dim3(16, NTOK / 64), 256, 0, stream>>>(T, WOUT, NTOK, 1024, 1024, EpiR1{x, MOD, out});
  k_ln1_router<<<2048, 256, 0, stream>>>(out, ln1_g, ln1_b, MOD, w_router, rbias, H2, TOPE, TOPW);
  k_moe_naive<<<NTOK, 256, 0, stream>>>(H2, WGU, WD, TOPE, TOPW, Y2);
  k_final<<<2048, 256, 0, stream>>>(out, Y2, MOD, ln2_g, ln2_b);
}
```

```cpp
#include <hip/hip_runtime.h>
#include <hip/hip_cooperative_groups.h>
#include <cstdio>
#include <cmath>
#include <cstdint>
namespace cg = cooperative_groups;

typedef unsigned short bf16_t;
typedef unsigned short f16_t;

constexpr int D = 1024, NB = 2, SEQ = 8192, CTX = 256;
constexpr int NTOK = NB * SEQ;
constexpr int NROW = NTOK + NB * CTX;
constexpr int PB_ROWS = SEQ + CTX;
constexpr int INW = 10240;
constexpr int NEXP = 64, EDIM = 256;
constexpr float LN_EPS = 1e-6f;
constexpr float ALPHA = 1.189207115002721f;
constexpr float ROUTED_SCALE = 2.5f;

__device__ __forceinline__ float bf2f(bf16_t v) { return __uint_as_float(((unsigned)v) << 16); }
__device__ __forceinline__ bf16_t f2bf(float f) { unsigned u = __float_as_uint(f); u += 0x7fffu + ((u >> 16) & 1u); return (bf16_t)(u >> 16); }
__device__ __forceinline__ float h2f(f16_t v) { _Float16 h; __builtin_memcpy(&h, &v, 2); return (float)h; }
__device__ __forceinline__ f16_t f2h(float f) { _Float16 h = (_Float16)f; f16_t v; __builtin_memcpy(&v, &h, 2); return v; }
__device__ __forceinline__ float sigmoidf_(float x) { return 1.0f / (1.0f + __expf(-x)); }
__device__ __forceinline__ float siluf_(float x) { return x / (1.0f + __expf(-x)); }
__device__ __forceinline__ float wave_sum(float v) {
#pragma unroll
  for (int o = 32; o >= 1; o >>= 1) v += __shfl_xor(v, o);
  return v;
}

constexpr size_t MiB = 1ull << 20;
constexpr size_t OFF_MOD = 0;
constexpr size_t OFF_LBF = OFF_MOD + 3 * 6144 * 4;
constexpr size_t OFF_LBB = OFF_LBF + 4096;
constexpr size_t OFF_ROPE = OFF_LBB + 4096;
constexpr size_t OFF_CNT = OFF_ROPE + 128 * 16 * 2 * 4;
constexpr size_t OFF_TOPE = 1 * MiB;
constexpr size_t OFF_TOPW = OFF_TOPE + NTOK * 8 * 4;
constexpr size_t OFF_TOPP = OFF_TOPW + NTOK * 8 * 4;
constexpr size_t OFF_LIST = 3 * MiB;
constexpr size_t OFF_LISTW = 8 * MiB;
constexpr size_t OFF_ACT = 67 * MiB;
constexpr size_t OFF_Y = 147 * MiB;
constexpr int Y_TILES = 288;
constexpr size_t OFF_WIN = 8 * MiB;
constexpr size_t OFF_WA = OFF_WIN + 20 * MiB;
constexpr size_t OFF_WB = OFF_WA + 2 * MiB;
constexpr size_t OFF_WOUT = OFF_WB + 2 * MiB;
constexpr size_t OFF_H = 34 * MiB;
constexpr size_t PSZ = (size_t)PB_ROWS * 1024 * 2;
constexpr size_t OFF_P = 67 * MiB;
constexpr size_t OFF_Q = OFF_P + 0 * PSZ, OFF_LF = OFF_P + 1 * PSZ, OFF_LB = OFF_P + 2 * PSZ, OFF_I = OFF_P + 3 * PSZ, OFF_OG = OFF_P + 4 * PSZ,
                 OFF_QR = OFF_P + 5 * PSZ, OFF_QN = OFF_P + 6 * PSZ, OFF_KN = OFF_P + 7 * PSZ, OFF_V = OFF_P + 8 * PSZ;
constexpr size_t OFF_E = OFF_P + 9 * PSZ;
constexpr size_t OFF_GA = OFF_P;
constexpr size_t OFF_GB = OFF_P + 32 * MiB;
constexpr size_t OFF_T1 = OFF_P + 64 * MiB;
constexpr size_t OFF_T = OFF_P + 128 * MiB;
constexpr size_t OFF_WGU = 230 * MiB;
constexpr size_t OFF_WD = 295 * MiB;
constexpr size_t OFF_H2 = OFF_H;
constexpr size_t OFF_Y2 = OFF_P;

__device__ __forceinline__ void transpose_tile32(const float* __restrict__ src, int src_ld, bf16_t* __restrict__ dst, int dst_ld, float (*t)[33]) {
  const int tx = threadIdx.x & 31, ty = threadIdx.x >> 5;
#pragma unroll
  for (int i = 0; i < 4; ++i) t[ty + 8 * i][tx] = src[(size_t)(ty + 8 * i) * src_ld + tx];
  __syncthreads();
#pragma unroll
  for (int i = 0; i < 4; ++i) dst[(size_t)(ty + 8 * i) * dst_ld + tx] = f2bf(t[tx][ty + 8 * i]);
  __syncthreads();
}
__global__ void __launch_bounds__(256) k_transpose(const float* __restrict__ W, bf16_t* __restrict__ Wt, int K, int N) {
  __shared__ float t[32][33];
  const int tn = N / 32, tk = K / 32;
  for (int tile = blockIdx.x; tile < tn * tk; tile += gridDim.x) {
    const int kn = tile % tn, kk = tile / tn;
    transpose_tile32(W + (size_t)kk * 32 * N + kn * 32, N, Wt + (size_t)kn * 32 * K + kk * 32, K, t);
  }
}
__global__ void __launch_bounds__(256) k_conv_gu(const float* __restrict__ weg, const float* __restrict__ weu, const float* __restrict__ wsg, const float* __restrict__ wsu, bf16_t* __restrict__ WGU) {
  __shared__ float t[32][33];
  for (int tile = blockIdx.x; tile < 65 * 16 * 32; tile += gridDim.x) {
    const int kk = tile & 31, rt = (tile >> 5) & 15, e = tile >> 9;
    const int r0 = rt * 32, pn = r0 >> 8, bj = (r0 >> 7) & 1, c0 = r0 & 127, f0 = pn * 128 + c0;
    const float* src = (e < 64) ? ((bj ? weu : weg) + (size_t)e * 1024 * 256) : (bj ? wsu : wsg);
    transpose_tile32(src + (size_t)kk * 32 * 256 + f0, 256, WGU + ((size_t)e * 512 + r0) * 1024 + kk * 32, 1024, t);
  }
}
__global__ void __launch_bounds__(256) k_conv_d(const float* __restrict__ wed, const float* __restrict__ wsd, bf16_t* __restrict__ WD) {
  __shared__ float t[32][33];
  for (int tile = blockIdx.x; tile < 65 * 32 * 8; tile += gridDim.x) {
    const int ft = tile & 7, nt = (tile >> 3) & 31, e = tile >> 8;
    const float* src = (e < 64) ? (wed + (size_t)e * 256 * 1024) : wsd;
    transpose_tile32(src + (size_t)ft * 32 * 1024 + nt * 32, 1024, WD + ((size_t)e * 1024 + nt * 32) * 256 + ft * 32, 256, t);
  }
}
__global__ void __launch_bounds__(256) k_prep_small(const float* __restrict__ c, const float* __restrict__ c_ctx, const float* __restrict__ w_ada, const float* __restrict__ b_ada,
                                                    const float* __restrict__ lbf_in, const float* __restrict__ lbb_in, float* mod, float* lbf, float* lbb, float* rope, int* cnt) {
  const int gtid = blockIdx.x * 256 + threadIdx.x, gsz = gridDim.x * 256;
  for (int j = gtid; j < 6144; j += gsz) {
    float a0 = 0.f, a1 = 0.f, a2 = 0.f;
    for (int k = 0; k < 1024; ++k) {
      const float w = w_ada[(size_t)k * 6144 + j];
      a0 += siluf_(c[k]) * w; a1 += siluf_(c[1024 + k]) * w; a2 += siluf_(c_ctx[k]) * w;
    }
    const float bb = b_ada[j];
    mod[j] = a0 + bb; mod[6144 + j] = a1 + bb; mod[2 * 6144 + j] = a2 + bb;
  }
  for (int j = gtid; j < 1024; j += gsz) {
    { const float x0 = lbf_in[j], x1 = lbf_in[1024 + j], m = fmaxf(x0, x1); const float e0 = expf(x0 - m), e1 = expf(x1 - m); lbf[j] = e0 / (e0 + e1); }
    { const float x0 = lbb_in[j], x1 = lbb_in[1024 + j], m = fmaxf(x0, x1); const float e0 = expf(x0 - m), e1 = expf(x1 - m); lbb[j] = e0 / (e0 + e1); }
  }
  for (int j = gtid; j < 128 * 16; j += gsz) {
    const int p = j >> 4, i = j & 15;
    const float inv = powf(10000.0f, -(float)(2 * i) / 32.0f);
    const float ang = (float)p * inv;
    rope[2 * j] = cosf(ang); rope[2 * j + 1] = sinf(ang);
  }
  for (int j = gtid; j < 256; j += gsz) cnt[j] = 0;
}

__global__ void __launch_bounds__(256) k_ln_mod(const float* __restrict__ x, const float* __restrict__ ctx, const float* __restrict__ mod, bf16_t* __restrict__ H) {
  const int lane = threadIdx.x & 63, wid = threadIdx.x >> 6;
  for (int row = blockIdx.x * 4 + wid; row < NROW; row += gridDim.x * 4) {
    const float* src = row < NTOK ? x + (size_t)row * D : ctx + (size_t)(row - NTOK) * D;
    const int mr = row < NTOK ? (row >> 13) : 2;
    const float* sh = mod + mr * 6144, *sc = sh + 1024;
    float4 v[4]; float s = 0.f;
#pragma unroll
    for (int j = 0; j < 4; ++j) { v[j] = *(const float4*)(src + j * 256 + lane * 4); s += v[j].x + v[j].y + v[j].z + v[j].w; }
    const float mu = wave_sum(s) * (1.0f / D);
    float q = 0.f;
#pragma unroll
    for (int j = 0; j < 4; ++j) { v[j].x -= mu; v[j].y -= mu; v[j].z -= mu; v[j].w -= mu; q += v[j].x * v[j].x + v[j].y * v[j].y + v[j].z * v[j].z + v[j].w * v[j].w; }
    const float rstd = rsqrtf(wave_sum(q) * (1.0f / D) + LN_EPS);
#pragma unroll
    for (int j = 0; j < 4; ++j) {
      const int k = j * 256 + lane * 4;
      const float4 a = *(const float4*)(sc + k), b = *(const float4*)(sh + k);
      ushort4 o;
      o.x = f2bf(v[j].x * rstd * (1.f + a.x) + b.x); o.y = f2bf(v[j].y * rstd * (1.f + a.y) + b.y);
      o.z = f2bf(v[j].z * rstd * (1.f + a.z) + b.z); o.w = f2bf(v[j].w * rstd * (1.f + a.w) + b.w);
      *(ushort4*)(H + (size_t)row * D + k) = o;
    }
  }
}

template <class Epi>
__global__ void __launch_bounds__(256) k_gemm_naive(const bf16_t* __restrict__ A, const bf16_t* __restrict__ Bt, int M, int N, int K, Epi epi) {
  __shared__ float As[32][65], Bs[32][65];
  const int tx = threadIdx.x & 15, ty = threadIdx.x >> 4;
  const int m0 = blockIdx.y * 64, n0 = blockIdx.x * 64;
  float acc[4][4];
#pragma unroll
  for (int i = 0; i < 4; ++i)
#pragma unroll
    for (int j = 0; j < 4; ++j) acc[i][j] = 0.f;
  const int r = threadIdx.x >> 2, ks = (threadIdx.x & 3) * 8;
  for (int k0 = 0; k0 < K; k0 += 32) {
    const uint4 av = *(const uint4*)(A + (size_t)(m0 + r) * K + k0 + ks);
    const uint4 bv = *(const uint4*)(Bt + (size_t)(n0 + r) * K + k0 + ks);
    const unsigned aw[4] = {av.x, av.y, av.z, av.w}, bw[4] = {bv.x, bv.y, bv.z, bv.w};
#pragma unroll
    for (int j = 0; j < 4; ++j) {
      As[ks + 2 * j][r] = __uint_as_float(aw[j] << 16); As[ks + 2 * j + 1][r] = __uint_as_float(aw[j] & 0xffff0000u);
      Bs[ks + 2 * j][r] = __uint_as_float(bw[j] << 16); Bs[ks + 2 * j + 1][r] = __uint_as_float(bw[j] & 0xffff0000u);
    }
    __syncthreads();
#pragma unroll 8
    for (int kk = 0; kk < 32; ++kk) {
      float a[4], b[4];
#pragma unroll
      for (int i = 0; i < 4; ++i) { a[i] = As[kk][ty + 16 * i]; b[i] = Bs[kk][tx + 16 * i]; }
#pragma unroll
      for (int i = 0; i < 4; ++i)
#pragma unroll
        for (int j = 0; j < 4; ++j) acc[i][j] += a[i] * b[j];
    }
    __syncthreads();
  }
#pragma unroll
  for (int i = 0; i < 4; ++i) epi(m0 + ty + 16 * i, n0, tx, acc[i]);
}

struct EpiS2 {
  bf16_t *Q, *I, *OG, *QR, *QN, *KN, *V; f16_t *LF, *LB; const float *lbf, *lbb, *rope; int row_off; int is_ctx;
  __device__ void operator()(int row, int n0, int tx, const float* v) const {
    const int rb = row + row_off, cb = n0 >> 10;
    const size_t ob = (size_t)rb * 1024 + (n0 & 1023) + tx;
    if (cb == 0) { for (int j = 0; j < 4; ++j) Q[ob + 16 * j] = f2bf(siluf_(v[j])); }
    else if (cb == 1 || cb == 2) {
      const float* lb = cb == 1 ? lbf : lbb; f16_t* dst = cb == 1 ? LF : LB;
      for (int j = 0; j < 4; ++j) { const float l = lb[(n0 & 1023) + tx + 16 * j]; dst[ob + 16 * j] = f2h(logf(l + (1.f - l) * sigmoidf_(v[j]))); }
    }
    else if (cb == 3) { for (int j = 0; j < 4; ++j) I[(size_t)((n0 & 1023) + tx + 16 * j) * PB_ROWS + rb] = f2bf(v[j]); }
    else if (cb == 4) { for (int j = 0; j < 4; ++j) OG[ob + 16 * j] = f2bf(siluf_(v[j])); }
    else if (cb == 5 || cb == 6) {
      float r[4] = {v[0], v[1], v[2], v[3]};
      if (!is_ctx) {
        const int s = row, pr = s >> 6, pc = s & 63;
        const float c0 = rope[(pr * 16 + tx) * 2], s0 = rope[(pr * 16 + tx) * 2 + 1], c1 = rope[(pc * 16 + tx) * 2], s1 = rope[(pc * 16 + tx) * 2 + 1];
        r[0] = v[0] * c0 - v[1] * s0; r[1] = v[0] * s0 + v[1] * c0; r[2] = v[2] * c1 - v[3] * s1; r[3] = v[2] * s1 + v[3] * c1;
      }
      if (cb == 5) { for (int j = 0; j < 4; ++j) { QN[ob + 16 * j] = f2bf(v[j] * 0.125f); QR[ob + 16 * j] = f2bf(r[j] * 0.125f); } }
      else { for (int j = 0; j < 4; ++j) KN[ob + 16 * j] = f2bf(r[j]); }
    }
    else if (cb == 7) { for (int j = 0; j < 4; ++j) V[(size_t)((n0 & 1023) + tx + 16 * j) * PB_ROWS + rb] = f2bf(v[j]); }
  }
};
struct EpiSigmoid { bf16_t* O; __device__ void operator()(int row, int n0, int tx, const float* v) const { for (int j = 0; j < 4; ++j) O[(size_t)row * 1024 + n0 + tx + 16 * j] = f2bf(sigmoidf_(v[j])); } };
struct EpiT1 { const bf16_t* G; float* T1; __device__ void operator()(int row, int n0, int tx, const float* v) const { for (int j = 0; j < 4; ++j) { const size_t o = (size_t)row * 1024 + n0 + tx + 16 * j; T1[o] = bf2f(G[o]) * v[j]; } } };
struct EpiT2 { const bf16_t* G; const float* T1; bf16_t* T; __device__ void operator()(int row, int n0, int tx, const float* v) const { for (int j = 0; j < 4; ++j) { const size_t o = (size_t)row * 1024 + n0 + tx + 16 * j; T[o] = f2bf(T1[o] + bf2f(G[o]) * v[j]); } } };
struct EpiR1 { const float* x; const float* mod; float* R1; __device__ void operator()(int row, int n0, int tx, const float* v) const {
    const float* g1 = mod + (row >> 13) * 6144 + 2048;
    for (int j = 0; j < 4; ++j) { const int col = n0 + tx + 16 * j; const size_t o = (size_t)row * 1024 + col; R1[o] = ALPHA * x[o] + g1[col] * v[j]; } } };

__global__ void __launch_bounds__(128) k_hg_naive(const bf16_t* __restrict__ Q, const f16_t* __restrict__ LF, const f16_t* __restrict__ LB, const bf16_t* __restrict__ I, float* __restrict__ Of, float* __restrict__ Ob) {
  __shared__ float sf[16][128], sk[16][128], sq[16][128];
  const int h = blockIdx.x, dir = blockIdx.y, v = threadIdx.x;
  const f16_t* LG = dir ? LB : LF; float* O = dir ? Ob : Of;
  float S[128];
#pragma unroll
  for (int k = 0; k < 128; ++k) S[k] = 0.f;
  for (int t0 = 0; t0 < CTX + SEQ; t0 += 16) {
    for (int j = 0; j < 16; ++j) {
      const int t = t0 + j;
      const int rb = t < CTX ? (SEQ + (dir ? CTX - 1 - t : t)) : (dir ? SEQ - 1 - (t - CTX) : (t - CTX));
      const float f = __expf(h2f(LG[(size_t)rb * 1024 + h * 128 + v]));
      sf[j][v] = f; sk[j][v] = 1.f - f; sq[j][v] = bf2f(Q[(size_t)rb * 1024 + h * 128 + v]);
    }
    __syncthreads();
    for (int j = 0; j < 16; ++j) {
      const int t = t0 + j;
      const int rb = t < CTX ? (SEQ + (dir ? CTX - 1 - t : t)) : (dir ? SEQ - 1 - (t - CTX) : (t - CTX));
      const float vv = bf2f(I[(size_t)(h * 128 + v) * PB_ROWS + rb]);
      float o = 0.f;
#pragma unroll
      for (int k = 0; k < 128; ++k) { S[k] = sf[j][k] * S[k] + sk[j][k] * vv; o += S[k] * sq[j][k]; }
      if (t >= CTX) O[(size_t)rb * 1024 + h * 128 + v] = o;
    }
    __syncthreads();
  }
}
__global__ void __launch_bounds__(256) k_hg_readout(const float* __restrict__ Of, const float* __restrict__ Ob, const bf16_t* __restrict__ OG, const float* __restrict__ g, bf16_t* __restrict__ YH  ) {
  const int lane = threadIdx.x & 63, wid = threadIdx.x >> 6;
  for (int u = blockIdx.x * 4 + wid; u < SEQ * 8; u += gridDim.x * 4) {
    const int s = u >> 3, h = u & 7; const size_t o = (size_t)s * 1024 + h * 128 + lane * 2;
    const float a = Of[o] + Ob[o], b = Of[o + 1] + Ob[o + 1];
    const float ms = wave_sum(a * a + b * b) * (1.0f / 128.0f);
    const float r = rsqrtf(ms + LN_EPS);
    YH[o] = f2bf(a * r * g[h * 128 + lane * 2] * bf2f(OG[o])); YH[o + 1] = f2bf(b * r * g[h * 128 + lane * 2 + 1] * bf2f(OG[o + 1]));
  }
}

__global__ void __launch_bounds__(256) k_na_naive(const bf16_t* __restrict__ QR, const bf16_t* __restrict__ QN, const bf16_t* __restrict__ KN, const bf16_t* __restrict__ V, const float* __restrict__ rpb, bf16_t* __restrict__ YN) {
  const int idx = blockIdx.x * 256 + threadIdx.x; const int hn = idx >> 13, s = idx & 8191;
  const int r = s >> 6, c = s & 63;
  float qr[64], o[64];
  const size_t qo = (size_t)s * 1024 + hn * 64;
#pragma unroll
  for (int d = 0; d < 64; ++d) { qr[d] = bf2f(QR[qo + d]); o[d] = 0.f; }
  float m = -3.0e38f, l = 0.f;
  const int row_start = min(max(r - 4, 0), 120), g = c >> 4, blk_start = min(max(16 * g - 8, 0), 32), col_start = min(max(c - 8, 0), 48);
  for (int kr = 0; kr < 8; ++kr)
    for (int kc = 0; kc < 32; ++kc) {
      const int krow = row_start + kr, kcol = blk_start + kc;
      if (kcol < col_start || kcol >= col_start + 16) continue;
      const size_t ko = (size_t)(krow * 64 + kcol) * 1024 + hn * 64;
      float sc = 0.f;
#pragma unroll
      for (int d = 0; d < 64; ++d) sc += qr[d] * bf2f(KN[ko + d]);
      const int dr = krow - r + 7, dc = min(max(kcol - c + 15, 0), 30);
      sc += rpb[(hn * 15 + dr) * 31 + dc];
      if (sc > m) { const float f = __expf(m - sc); l *= f;
#pragma unroll
        for (int d = 0; d < 64; ++d) o[d] *= f;
        m = sc; }
      const float p = __expf(sc - m); l += p;
#pragma unroll
      for (int d = 0; d < 64; ++d) o[d] += p * bf2f(V[(size_t)(hn * 64 + d) * PB_ROWS + krow * 64 + kcol]);
    }
#pragma unroll
  for (int d = 0; d < 64; ++d) qr[d] = bf2f(QN[qo + d]);
  for (int j = 0; j < CTX; ++j) {
    const size_t ko = (size_t)(SEQ + j) * 1024 + hn * 64;
    float sc = 0.f;
#pragma unroll
    for (int d = 0; d < 64; ++d) sc += qr[d] * bf2f(KN[ko + d]);
    if (sc > m) { const float f = __expf(m - sc); l *= f;
#pragma unroll
      for (int d = 0; d < 64; ++d) o[d] *= f;
      m = sc; }
    const float p = __expf(sc - m); l += p;
#pragma unroll
    for (int d = 0; d < 64; ++d) o[d] += p * bf2f(V[(size_t)(hn * 64 + d) * PB_ROWS + SEQ + j]);
  }
  const float il = 1.0f / l;
#pragma unroll
  for (int d = 0; d < 64; ++d) YN[qo + d] = f2bf(o[d] * il);
}

__global__ void __launch_bounds__(256) k_ln1_router(float* __restrict__ X1  , const float* __restrict__ ln_g, const float* __restrict__ ln_b, const float* __restrict__ mod,
                                                    const float* __restrict__ w_router, const float* __restrict__ rbias, bf16_t* __restrict__ H2, int* __restrict__ TOPE, float* __restrict__ TOPW,
                                                    int* __restrict__ CNT, int* __restrict__ TOPP, int* __restrict__ LIST, float* __restrict__ LISTW) {
  const int lane = threadIdx.x & 63, wid = threadIdx.x >> 6;
  for (int row = blockIdx.x * 4 + wid; row < NTOK; row += gridDim.x * 4) {
    float* xr = X1 + (size_t)row * D;
    const float* sh = mod + (row >> 13) * 6144 + 3 * 1024, *sc = sh + 1024;
    float vals[16]; float s = 0.f;
#pragma unroll
    for (int j = 0; j < 4; ++j) { const float4 t = *(const float4*)(xr + j * 256 + lane * 4); vals[4 * j] = t.x; vals[4 * j + 1] = t.y; vals[4 * j + 2] = t.z; vals[4 * j + 3] = t.w; s += t.x + t.y + t.z + t.w; }
    float mu = wave_sum(s) * (1.0f / D), q = 0.f;
#pragma unroll
    for (int i = 0; i < 16; ++i) { vals[i] -= mu; q += vals[i] * vals[i]; }
    float rstd = rsqrtf(wave_sum(q) * (1.0f / D) + LN_EPS);
    s = 0.f;
#pragma unroll
    for (int j = 0; j < 4; ++j) {
      const int k = j * 256 + lane * 4;
      const float4 g = *(const float4*)(ln_g + k), b = *(const float4*)(ln_b + k);
      vals[4 * j] = vals[4 * j] * rstd * g.x + b.x; vals[4 * j + 1] = vals[4 * j + 1] * rstd * g.y + b.y; vals[4 * j + 2] = vals[4 * j + 2] * rstd * g.z + b.z; vals[4 * j + 3] = vals[4 * j + 3] * rstd * g.w + b.w;
      *(float4*)(xr + k) = make_float4(vals[4 * j], vals[4 * j + 1], vals[4 * j + 2], vals[4 * j + 3]);
      s += vals[4 * j] + vals[4 * j + 1] + vals[4 * j + 2] + vals[4 * j + 3];
    }
    mu = wave_sum(s) * (1.0f / D); q = 0.f;
#pragma unroll
    for (int i = 0; i < 16; ++i) { vals[i] -= mu; q += vals[i] * vals[i]; }
    rstd = rsqrtf(wave_sum(q) * (1.0f / D) + LN_EPS);
#pragma unroll
    for (int j = 0; j < 4; ++j) {
      const int k = j * 256 + lane * 4;
      const float4 a = *(const float4*)(sc + k), b = *(const float4*)(sh + k);
      vals[4 * j] = vals[4 * j] * rstd * (1.f + a.x) + b.x; vals[4 * j + 1] = vals[4 * j + 1] * rstd * (1.f + a.y) + b.y; vals[4 * j + 2] = vals[4 * j + 2] * rstd * (1.f + a.z) + b.z; vals[4 * j + 3] = vals[4 * j + 3] * rstd * (1.f + a.w) + b.w;
      ushort4 o; o.x = f2bf(vals[4 * j]); o.y = f2bf(vals[4 * j + 1]); o.z = f2bf(vals[4 * j + 2]); o.w = f2bf(vals[4 * j + 3]);
      *(ushort4*)(H2 + (size_t)row * D + k) = o;
    }
    float logit = 0.f;
#pragma unroll
    for (int j = 0; j < 4; ++j)
      for (int l = 0; l < 64; ++l)
#pragma unroll
        for (int i = 0; i < 4; ++i) { const float hv = __shfl(vals[4 * j + i], l); logit += hv * w_router[(size_t)(j * 256 + l * 4 + i) * 64 + lane]; }
    const float score = sigmoidf_(logit), sel = score + rbias[lane];
    float m1 = sel;
    m1 = fmaxf(m1, __shfl_xor(m1, 1)); m1 = fmaxf(m1, __shfl_xor(m1, 2)); m1 = fmaxf(m1, __shfl_xor(m1, 4));
    const unsigned long long bal = __ballot(sel == m1), gm = 0xFFull << (8 * (lane >> 3));
    const int first = __ffsll((unsigned long long)(bal & gm)) - 1;
    float m2 = (lane == first) ? -INFINITY : sel;
    m2 = fmaxf(m2, __shfl_xor(m2, 1)); m2 = fmaxf(m2, __shfl_xor(m2, 2)); m2 = fmaxf(m2, __shfl_xor(m2, 4));
    const float gscore = m1 + m2; const int g = lane >> 3;
    int rank_g = 0;
#pragma unroll
    for (int gg = 0; gg < 8; ++gg) { const float gs = __shfl(gscore, gg * 8); rank_g += (gs > gscore) || (gs == gscore && gg < g); }
    const bool gsel = rank_g < 4;
    const float msel = gsel ? sel : -INFINITY;
    int rank_e = 0;
    for (int e = 0; e < 64; ++e) { const float v = __shfl(msel, e); rank_e += (v > msel) || (v == msel && e < lane); }
    const bool chosen = gsel && rank_e < 8;
    const float w = chosen ? score : 0.f;
    const float wsum = wave_sum(w);
    if (chosen) {
      const float wn = w / wsum * ROUTED_SCALE;
      const int pos = atomicAdd(&CNT[lane], 1);
      TOPE[row * 8 + rank_e] = lane; TOPW[row * 8 + rank_e] = wn; TOPP[row * 8 + rank_e] = pos;
      LIST[lane * 16384 + pos] = row; LISTW[lane * 16384 + pos] = wn;
    }
  }
}

__global__ void __launch_bounds__(256) k_moe_naive(const bf16_t* __restrict__ H2, const bf16_t* __restrict__ WGU, const bf16_t* __restrict__ WD, const int* __restrict__ TOPE, const float* __restrict__ TOPW, bf16_t* __restrict__ Y2) {
  __shared__ float hs[1024], act[256];
  const int t = blockIdx.x, tid = threadIdx.x;
  for (int k = tid; k < 1024; k += 256) hs[k] = bf2f(H2[(size_t)t * 1024 + k]);
  __syncthreads();
  float y[4] = {0.f, 0.f, 0.f, 0.f};
  for (int slot = 0; slot < 9; ++slot) {
    const int e = slot < 8 ? TOPE[t * 8 + slot] : 64; const float w = slot < 8 ? TOPW[t * 8 + slot] : 1.0f;
    const bf16_t* wg = WGU + ((size_t)e * 512 + (tid >> 7) * 256 + (tid & 127)) * 1024, *wu = wg + 128 * 1024;
    float a = 0.f, u = 0.f;
    for (int k = 0; k < 1024; k += 8) {
      const uint4 gv = *(const uint4*)(wg + k), uv = *(const uint4*)(wu + k);
      const unsigned gw[4] = {gv.x, gv.y, gv.z, gv.w}, uw[4] = {uv.x, uv.y, uv.z, uv.w};
#pragma unroll
      for (int j = 0; j < 4; ++j) {
        a += hs[k + 2 * j] * __uint_as_float(gw[j] << 16) + hs[k + 2 * j + 1] * __uint_as_float(gw[j] & 0xffff0000u);
        u += hs[k + 2 * j] * __uint_as_float(uw[j] << 16) + hs[k + 2 * j + 1] * __uint_as_float(uw[j] & 0xffff0000u);
      }
    }
    act[tid] = bf2f(f2bf(siluf_(a) * u * w));
    __syncthreads();
#pragma unroll
    for (int j = 0; j < 4; ++j) {
      const bf16_t* wd = WD + ((size_t)e * 1024 + tid + 256 * j) * 256; float acc = 0.f;
      for (int f = 0; f < 256; f += 8) {
        const uint4 dv = *(const uint4*)(wd + f); const unsigned dw[4] = {dv.x, dv.y, dv.z, dv.w};
#pragma unroll
        for (int i = 0; i < 4; ++i) acc += act[f + 2 * i] * __uint_as_float(dw[i] << 16) + act[f + 2 * i + 1] * __uint_as_float(dw[i] & 0xffff0000u);
      }
      y[j] += acc;
    }
    __syncthreads();
  }
#pragma unroll
  for (int j = 0; j < 4; ++j) Y2[(size_t)t * 1024 + tid + 256 * j] = f2bf(y[j]);
}

__global__ void __launch_bounds__(256) k_final(float* __restrict__ OUT  , const bf16_t* __restrict__ Y2, const float* __restrict__ mod, const float* __restrict__ ln_g, const float* __restrict__ ln_b) {
  const int lane = threadIdx.x & 63, wid = threadIdx.x >> 6;
  for (int row = blockIdx.x * 4 + wid; row < NTOK; row += gridDim.x * 4) {
    float* xr = OUT + (size_t)row * D; const float* g2 = mod + (row >> 13) * 6144 + 5 * 1024;
    float vals[16]; float s = 0.f;
#pragma unroll
    for (int j = 0; j < 4; ++j) {
      const int k = j * 256 + lane * 4;
      const float4 t = *(const float4*)(xr + k), gg = *(const float4*)(g2 + k); const ushort4 yv = *(const ushort4*)(Y2 + (size_t)row * D + k);
      vals[4 * j] = ALPHA * t.x + gg.x * bf2f(yv.x); vals[4 * j + 1] = ALPHA * t.y + gg.y * bf2f(yv.y); vals[4 * j + 2] = ALPHA * t.z + gg.z * bf2f(yv.z); vals[4 * j + 3] = ALPHA * t.w + gg.w * bf2f(yv.w);
      s += vals[4 * j] + vals[4 * j + 1] + vals[4 * j + 2] + vals[4 * j + 3];
    }
    const float mu = wave_sum(s) * (1.0f / D); float q = 0.f;
#pragma unroll
    for (int i = 0; i < 16; ++i) { vals[i] -= mu; q += vals[i] * vals[i]; }
    const float rstd = rsqrtf(wave_sum(q) * (1.0f / D) + LN_EPS);
#pragma unroll
    for (int j = 0; j < 4; ++j) {
      const int k = j * 256 + lane * 4;
      const float4 g = *(const float4*)(ln_g + k), b = *(const float4*)(ln_b + k);
      *(float4*)(xr + k) = make_float4(vals[4 * j] * rstd * g.x + b.x, vals[4 * j + 1] * rstd * g.y + b.y, vals[4 * j + 2] * rstd * g.z + b.z, vals[4 * j + 3] * rstd * g.w + b.w);
    }
  }
}

namespace pg8 {
#define PG8_LAS __attribute__((address_space(3)))
typedef unsigned short bf16_t;
typedef short bf16x8 __attribute__((ext_vector_type(8)));
typedef float f32x4 __attribute__((ext_vector_type(4)));
typedef unsigned u32x4 __attribute__((ext_vector_type(4)));
constexpr int BM = 256, BK = 64, HALF = 128, HTB = HALF * BK * 2  , STAGE_BYTES = 8 * HTB, NXCD = 8, WGM = 8;

__host__ __device__ __forceinline__ int lds_byte(int r, int c) { const int st = (r >> 4) * 2 + (c >> 5), rr = r & 15, cc = c & 31, ob = rr * 64 + cc * 2; return st * 1024 + (ob ^ (((ob >> 9) & 1) << 5)); }
__host__ __device__ __forceinline__ void stage_rc(int b, int& R, int& C) { const int st = b / 1024, sb = b % 1024, swz = sb ^ (((sb >> 9) & 1) << 5); R = (st >> 1) * 16 + swz / 64; C = (st & 1) * 32 + (swz % 64) / 2; }
__host__ __device__ __forceinline__ int perm32(int rho) { const int n = rho >> 4, i = rho & 15; return 8 * (i >> 2) + 4 * n + (i & 3); }

struct Unit { int pm, pn; };
struct Gemm { const bf16_t* A; const bf16_t* Bt; int M, N, K; };

struct StaticOrder {
    int nM, nN, nwg, G, c;
    __host__ __device__ void init(int M, int N, int G_, int c_) { nM = M / BM; nN = N / BM; nwg = nM * nN; G = G_; c = c_; }
    __host__ __device__ bool next(int i, Unit& u) const {
        const long L = (long)i * G + c; if (L >= nwg) return false;
        int wgid = (int)L; { const int q = nwg / NXCD, r = nwg % NXCD, xcd = wgid % NXCD, off = wgid / NXCD; wgid = (xcd < r ? xcd * (q + 1) : r * (q + 1) + (xcd - r) * q) + off; }
        const int nig = WGM * nN, gid = wgid / nig, fm = gid * WGM, gsz = (nM - fm) < WGM ? (nM - fm) : WGM;
        u.pm = fm + ((wgid % nig) % gsz); u.pn = (wgid % nig) / gsz; return true;
    }
    __device__ __forceinline__ void a_ready(const Unit&) const {}
    __device__ __forceinline__ void done(const Unit&) const {}
};
typedef float f32x2_t __attribute__((ext_vector_type(2))); typedef __bf16 bf16x2_t __attribute__((ext_vector_type(2)));
__device__ __forceinline__ unsigned cvt_pk_bf16(float lo, float hi) { f32x2_t v = {lo, hi}; bf16x2_t b = __builtin_convertvector(v, bf16x2_t); return __builtin_bit_cast(unsigned, b); }
template <class Epi, class Sched, bool ALIGN_EPI = false, bool SP2 = false>
__device__ __forceinline__ void gemm_phase(PG8_LAS unsigned char* lds, const Gemm g, const Sched& S, const Epi& E) {
    const int tid = threadIdx.x, wid = __builtin_amdgcn_readfirstlane(tid >> 6), lane = tid & 63, wr = wid >> 2, wc = wid & 3, fr = lane & 15, fq = lane >> 4;
    const int K = g.K, nt = K / BK;
    unsigned voffA[2], voffB[2];
#pragma unroll
    for (int i = 0; i < 2; ++i) { int R, C; stage_rc(tid * 16 + i * 8192, R, C); const int Rb = Epi::PERM ? ((R & ~31) + perm32(R & 31)) : R;
        voffA[i] = (unsigned)(R * K + C) * 2u; voffB[i] = (unsigned)(Rb * K + C) * 2u; }
    const size_t kstep = (size_t)(BK * 2);
    const size_t hstep = (size_t)HALF * K * 2;
    const size_t tstep = 2 * hstep;
    const unsigned ldsw = (unsigned)wid * 1024u;
    const int aoff = lds_byte(wr * 64 + fr, fq * 8), boff = lds_byte(wc * 32 + fr, fq * 8);
#define PG8_SA(b, h) (((b) * 2 + (h)) * HTB)
#define PG8_SB(b, h) ((4 + (b) * 2 + (h)) * HTB)
#define PG8_STAGE(bufoff, gbase, voff) do { _Pragma("unroll") for (int _i = 0; _i < 2; ++_i) \
        __builtin_amdgcn_global_load_lds((const unsigned*)((const char*)(gbase) + (voff)[_i]), (PG8_LAS unsigned*)(lds + (bufoff) + ldsw + _i * 8192), 16, 0, 0); } while (0)
#define PG8_LDA(dst, b, h) do { _Pragma("unroll") for (int m = 0; m < 4; ++m) _Pragma("unroll") for (int k = 0; k < 2; ++k) dst[m][k] = *(const PG8_LAS bf16x8*)(lds + PG8_SA(b, h) + aoff + m * 2048 + k * 1024); } while (0)
#define PG8_LDB(dst, b, h) do { _Pragma("unroll") for (int n = 0; n < 2; ++n) _Pragma("unroll") for (int k = 0; k < 2; ++k) dst[n][k] = *(const PG8_LAS bf16x8*)(lds + PG8_SB(b, h) + boff + n * 2048 + k * 1024); } while (0)
#define PG8_MMA(ai, bj, At, Bt) do { __builtin_amdgcn_s_setprio(1); _Pragma("unroll") for (int m = 0; m < 4; ++m) _Pragma("unroll") for (int n = 0; n < 2; ++n) _Pragma("unroll") for (int k = 0; k < 2; ++k) \
        acc[ai][bj][m][n] = __builtin_amdgcn_mfma_f32_16x16x32_bf16(Bt[n][k], At[m][k], acc[ai][bj][m][n], 0, 0, 0); __builtin_amdgcn_s_setprio(0); } while (0)
#define PG8_WAIT_V(n) asm volatile("s_waitcnt vmcnt(" #n ")" ::: "memory")
#define PG8_WAIT_L(n) asm volatile("s_waitcnt lgkmcnt(" #n ")" ::: "memory")
#define PG8_BAR __builtin_amdgcn_s_barrier()
#define PG8_SCHED __builtin_amdgcn_sched_barrier(0)
    Unit cur, nxt; int ui = 0;
    if (!S.next(0, cur)) return;
    f32x4 acc[2][2][4][2];
#pragma unroll
    for (int a = 0; a < 2; ++a)
#pragma unroll
        for (int b = 0; b < 2; ++b)
#pragma unroll
            for (int m = 0; m < 4; ++m)
#pragma unroll
                for (int n = 0; n < 2; ++n) acc[a][b][m][n] = (f32x4){0.f, 0.f, 0.f, 0.f};
    bf16x8 At[4][2], B0[2][2], B1[2][2];
    const char* cA = (const char*)g.A + (size_t)cur.pm * tstep; const char* cB = (const char*)g.Bt + (size_t)cur.pn * tstep;
    S.a_ready(cur);
    if constexpr (SP2) {
        PG8_STAGE(PG8_SB(0, 0), cB, voffB); PG8_STAGE(PG8_SB(0, 1), cB + hstep, voffB); PG8_STAGE(PG8_SA(0, 0), cA, voffA); PG8_STAGE(PG8_SA(0, 1), cA + hstep, voffA);
        if (wr == 1) PG8_BAR;
        PG8_WAIT_V(2); PG8_BAR;
        PG8_STAGE(PG8_SB(1, 0), cB + kstep, voffB); PG8_STAGE(PG8_SA(1, 0), cA + kstep, voffA); PG8_STAGE(PG8_SB(1, 1), cB + hstep + kstep, voffB);
        PG8_WAIT_V(6); PG8_BAR;
    } else {
        PG8_STAGE(PG8_SB(0, 0), cB, voffB); PG8_STAGE(PG8_SA(0, 0), cA, voffA); PG8_STAGE(PG8_SB(0, 1), cB + hstep, voffB); PG8_STAGE(PG8_SA(0, 1), cA + hstep, voffA);
        if (wr == 1) PG8_BAR;
        PG8_WAIT_V(4); PG8_BAR;
        PG8_STAGE(PG8_SB(1, 0), cB + kstep, voffB); PG8_STAGE(PG8_SA(1, 0), cA + kstep, voffA); PG8_STAGE(PG8_SB(1, 1), cB + hstep + kstep, voffB);
        PG8_WAIT_V(6); PG8_BAR;
    }
    for (;;) {
        const bool has_next = S.next(ui + 1, nxt);
        const char* nA = has_next ? (const char*)g.A + (size_t)nxt.pm * tstep : cA; const char* nB = has_next ? (const char*)g.Bt + (size_t)nxt.pn * tstep : cB;
        for (int t = 0; t < nt; t += 2) {
            const bool last = (t == nt - 2);
            const char* a1 = cA + (size_t)(t + 1) * kstep;
            const char* a2 = last ? nA : cA + (size_t)(t + 2) * kstep; const char* b2 = last ? nB : cB + (size_t)(t + 2) * kstep;
            const char* a3 = a2 + kstep; const char* b3 = b2 + kstep;
            if (last && has_next) S.a_ready(nxt);
            if constexpr (SP2) {
            PG8_LDB(B0, 0, 0); PG8_LDB(B1, 0, 1); PG8_SCHED; PG8_LDA(At, 0, 0); PG8_STAGE(PG8_SA(1, 1), a1 + hstep, voffA);
            PG8_WAIT_V(8); PG8_WAIT_L(0); PG8_BAR; PG8_MMA(0, 0, At, B0); PG8_MMA(0, 1, At, B1); PG8_BAR; PG8_SCHED;
            PG8_LDA(At, 0, 1); PG8_STAGE(PG8_SB(0, 0), b2, voffB); PG8_STAGE(PG8_SB(0, 1), b2 + hstep, voffB); PG8_STAGE(PG8_SA(0, 0), a2, voffA);
            PG8_WAIT_V(8); PG8_WAIT_L(0); PG8_BAR; PG8_MMA(1, 0, At, B0); PG8_MMA(1, 1, At, B1); PG8_BAR; PG8_SCHED;
            PG8_LDB(B0, 1, 0); PG8_LDB(B1, 1, 1); PG8_SCHED; PG8_LDA(At, 1, 0); PG8_STAGE(PG8_SA(0, 1), a2 + hstep, voffA);
            PG8_WAIT_V(8); PG8_WAIT_L(0); PG8_BAR; PG8_MMA(0, 0, At, B0); PG8_MMA(0, 1, At, B1); PG8_BAR; PG8_SCHED;
            PG8_LDA(At, 1, 1); PG8_STAGE(PG8_SB(1, 0), b3, voffB); PG8_STAGE(PG8_SB(1, 1), b3 + hstep, voffB); PG8_STAGE(PG8_SA(1, 0), a3, voffA);
            PG8_WAIT_V(8); PG8_WAIT_L(0); PG8_BAR; PG8_MMA(1, 0, At, B0); PG8_MMA(1, 1, At, B1); PG8_BAR; PG8_SCHED;
            } else {
            PG8_LDB(B0, 0, 0); PG8_SCHED; PG8_LDA(At, 0, 0); PG8_STAGE(PG8_SA(1, 1), a1 + hstep, voffA);
            PG8_WAIT_L(8); PG8_BAR; PG8_WAIT_L(0); PG8_MMA(0, 0, At, B0); PG8_BAR; PG8_SCHED;
            PG8_LDB(B1, 0, 1); PG8_STAGE(PG8_SB(0, 0), b2, voffB);
            PG8_BAR; PG8_WAIT_L(0); PG8_MMA(0, 1, At, B1); PG8_BAR;
            PG8_LDA(At, 0, 1); PG8_STAGE(PG8_SA(0, 0), a2, voffA);
            PG8_BAR; PG8_WAIT_L(0); PG8_MMA(1, 0, At, B0); PG8_BAR; PG8_SCHED;
            PG8_STAGE(PG8_SB(0, 1), b2 + hstep, voffB);
            PG8_WAIT_V(6); PG8_BAR; PG8_MMA(1, 1, At, B1); PG8_BAR;
            PG8_LDB(B0, 1, 0); PG8_SCHED; PG8_LDA(At, 1, 0); PG8_STAGE(PG8_SA(0, 1), a2 + hstep, voffA);
            PG8_WAIT_L(8); PG8_BAR; PG8_WAIT_L(0); PG8_MMA(0, 0, At, B0); PG8_BAR; PG8_SCHED;
            PG8_LDB(B1, 1, 1); PG8_STAGE(PG8_SB(1, 0), b3, voffB);
            PG8_BAR; PG8_WAIT_L(0); PG8_MMA(0, 1, At, B1); PG8_BAR;
            PG8_LDA(At, 1, 1); PG8_STAGE(PG8_SA(1, 0), a3, voffA);
            PG8_BAR; PG8_WAIT_L(0); PG8_MMA(1, 0, At, B0); PG8_BAR; PG8_SCHED;
            PG8_STAGE(PG8_SB(1, 1), b3 + hstep, voffB);
            PG8_WAIT_V(6); PG8_BAR; PG8_MMA(1, 1, At, B1); PG8_BAR;
            }
        }
        if constexpr (ALIGN_EPI) { if (wr == 0) PG8_BAR; }
        if constexpr (!Epi::AFTER_DRAIN) { E(acc, cur, wr, wc, fr, fq); S.done(cur); }
        if (!has_next) break;
#pragma unroll
        for (int a = 0; a < 2; ++a)
#pragma unroll
            for (int b = 0; b < 2; ++b)
#pragma unroll
                for (int m = 0; m < 4; ++m)
#pragma unroll
                    for (int n = 0; n < 2; ++n) acc[a][b][m][n] = (f32x4){0.f, 0.f, 0.f, 0.f};
        cur = nxt; cA = nA; cB = nB; ++ui;
        if constexpr (ALIGN_EPI) { if (wr == 1) PG8_BAR; }
    }
    PG8_WAIT_V(0);
    if constexpr (!ALIGN_EPI) { if (wr == 0) PG8_BAR; }
    PG8_BAR;
    if constexpr (Epi::AFTER_DRAIN) { E.fused(acc, cur, wr, wc, fr, fq, lds, wid, lane); S.done(cur); }
#undef PG8_SA
#undef PG8_SB
#undef PG8_STAGE
#undef PG8_LDA
#undef PG8_LDB
#undef PG8_MMA
#undef PG8_WAIT_V
#undef PG8_WAIT_L
#undef PG8_BAR
#undef PG8_SCHED
}
}

namespace pg8 {
typedef unsigned u32x2 __attribute__((ext_vector_type(2)));
__device__ __forceinline__ u32x2 pack4_bf16(f32x4 v) { u32x2 w; w.x = cvt_pk_bf16(v[0], v[1]); w.y = cvt_pk_bf16(v[2], v[3]); return w; }
__device__ __forceinline__ unsigned pk_f16(float a, float b) { typedef _Float16 h2v __attribute__((ext_vector_type(2))); h2v v = {(_Float16)a, (_Float16)b}; return __builtin_bit_cast(unsigned, v); }
__device__ __forceinline__ float fsigmoid(float x) { return __builtin_amdgcn_rcpf(1.0f + __expf(-x)); }
__device__ __forceinline__ f32x4 unpack4_bf16(u32x2 w) { f32x4 r; r[0] = __uint_as_float(w.x << 16); r[1] = __uint_as_float(w.x & 0xffff0000u); r[2] = __uint_as_float(w.y << 16); r[3] = __uint_as_float(w.y & 0xffff0000u); return r; }

struct OrderS2 {
  StaticOrder so; int b;
  __device__ void init(int b_, int G, int c) { b = b_; so.init(33 * 256, 8192, G, c); }
  __device__ bool next(int i, Unit& u) const { if (!so.next(i, u)) return false; u.pm = u.pm < 32 ? b * 32 + u.pm : 64 + b; return true; }
  __device__ __forceinline__ void a_ready(const Unit&) const {}
  __device__ __forceinline__ void done(const Unit&) const {}
};

struct EpiS2F {
  static constexpr bool PERM = false, AFTER_DRAIN = false;
  bf16_t *Q, *I, *OG, *QR, *QN, *KN, *V; bf16_t *LF, *LB; const float *lbf, *lbb, *rope; int b;
  __device__ __forceinline__ void operator()(const f32x4 (&acc)[2][2][4][2], const Unit& u, int wr, int wc, int fr, int fq) const {
    const bool is_ctx = u.pm >= 64;
    const int rbase = (is_ctx ? 8192 : (u.pm - b * 32) * 256) + wr * 64 + fr;
    const int cb = u.pn >> 2, cc0 = (u.pn & 3) * 256 + wc * 32 + 4 * fq;
    if (cb == 0 || cb == 4) {
      bf16_t* dst = cb == 0 ? Q : OG;
#pragma unroll
      for (int ai = 0; ai < 2; ++ai)
#pragma unroll
        for (int m = 0; m < 4; ++m) { bf16_t* rp = dst + (size_t)(rbase + ai * 128 + m * 16) * 1024 + cc0;
#pragma unroll
          for (int bj = 0; bj < 2; ++bj)
#pragma unroll
            for (int n = 0; n < 2; ++n) { f32x4 v = acc[ai][bj][m][n];
#pragma unroll
              for (int j = 0; j < 4; ++j) v[j] = v[j] * fsigmoid(v[j]);
              *(u32x2*)(rp + bj * 128 + n * 16) = pack4_bf16(v); } }
    } else if (cb == 1 || cb == 2) {
      bf16_t* dst = cb == 1 ? LF : LB; const float* lbp = (cb == 1 ? lbf : lbb) + cc0;
      f32x4 lb[2][2];
#pragma unroll
      for (int bj = 0; bj < 2; ++bj)
#pragma unroll
        for (int n = 0; n < 2; ++n) lb[bj][n] = *(const f32x4*)(lbp + bj * 128 + n * 16);
#pragma unroll
      for (int ai = 0; ai < 2; ++ai)
#pragma unroll
        for (int m = 0; m < 4; ++m) { bf16_t* rp = dst + (size_t)(rbase + ai * 128 + m * 16) * 1024 + cc0;
#pragma unroll
          for (int bj = 0; bj < 2; ++bj)
#pragma unroll
            for (int n = 0; n < 2; ++n) { f32x4 v = acc[ai][bj][m][n];
#pragma unroll
              for (int j = 0; j < 4; ++j) { const float l = lb[bj][n][j]; v[j] = __logf(l + (1.f - l) * fsigmoid(v[j])); }
              u32x2 w; w.x = pk_f16(v[0], v[1]); w.y = pk_f16(v[2], v[3]);
              *(u32x2*)(rp + bj * 128 + n * 16) = w; } }
    } else if (cb == 3 || cb == 7) {
      bf16_t* dst = (cb == 3 ? I : V) + (size_t)cc0 * PB_ROWS + rbase;
#pragma unroll
      for (int ai = 0; ai < 2; ++ai)
#pragma unroll
        for (int m = 0; m < 4; ++m)
#pragma unroll
          for (int bj = 0; bj < 2; ++bj)
#pragma unroll
            for (int n = 0; n < 2; ++n) { const u32x2 w = pack4_bf16(acc[ai][bj][m][n]); bf16_t* cp = dst + (size_t)(bj * 128 + n * 16) * PB_ROWS + ai * 128 + m * 16;
              cp[0] = (bf16_t)(w.x & 0xffffu); cp[PB_ROWS] = (bf16_t)(w.x >> 16); cp[2 * PB_ROWS] = (bf16_t)(w.y & 0xffffu); cp[3 * PB_ROWS] = (bf16_t)(w.y >> 16); }
    } else {
#pragma unroll
      for (int ai = 0; ai < 2; ++ai)
#pragma unroll
        for (int m = 0; m < 4; ++m) {
          const int rb = rbase + ai * 128 + m * 16; const size_t ro = (size_t)rb * 1024 + cc0;
          const int p = ((wc & 1) ? (rb & 63) : (rb >> 6)) & 127;
          const f32x4 cs0 = *(const f32x4*)(rope + (p * 16 + 4 * fq) * 2), cs1 = *(const f32x4*)(rope + (p * 16 + 4 * fq) * 2 + 4);
          f32x4 c, s; c[0] = cs0[0]; s[0] = cs0[1]; c[1] = cs0[2]; s[1] = cs0[3]; c[2] = cs1[0]; s[2] = cs1[1]; c[3] = cs1[2]; s[3] = cs1[3];
          if (is_ctx) { c = (f32x4){1.f, 1.f, 1.f, 1.f}; s = (f32x4){0.f, 0.f, 0.f, 0.f}; }
#pragma unroll
          for (int bj = 0; bj < 2; ++bj) {
            const f32x4 d0 = acc[ai][bj][m][0], d1 = acc[ai][bj][m][1];
            const f32x4 r0 = d0 * c - d1 * s, r1 = d0 * s + d1 * c;
            if (cb == 5) {
              *(u32x2*)(QN + ro + bj * 128) = pack4_bf16(d0 * 0.125f); *(u32x2*)(QN + ro + bj * 128 + 16) = pack4_bf16(d1 * 0.125f);
              *(u32x2*)(QR + ro + bj * 128) = pack4_bf16(r0 * 0.125f); *(u32x2*)(QR + ro + bj * 128 + 16) = pack4_bf16(r1 * 0.125f);
            } else {
              *(u32x2*)(KN + ro + bj * 128) = pack4_bf16(r0); *(u32x2*)(KN + ro + bj * 128 + 16) = pack4_bf16(r1);
            }
          }
        }
    }
  }
};
struct EpiGateF {
  static constexpr bool PERM = false, AFTER_DRAIN = false;
  bf16_t *GA, *GB;
  __device__ __forceinline__ void operator()(const f32x4 (&acc)[2][2][4][2], const Unit& u, int wr, int wc, int fr, int fq) const {
    bf16_t* dst = (u.pn < 4 ? GA : GB) + (size_t)(u.pm * 256 + wr * 64 + fr) * 1024 + (u.pn & 3) * 256 + wc * 32 + 4 * fq;
#pragma unroll
    for (int ai = 0; ai < 2; ++ai)
#pragma unroll
      for (int m = 0; m < 4; ++m) { bf16_t* rp = dst + (size_t)(ai * 128 + m * 16) * 1024;
#pragma unroll
        for (int bj = 0; bj < 2; ++bj)
#pragma unroll
          for (int n = 0; n < 2; ++n) { f32x4 v = acc[ai][bj][m][n];
#pragma unroll
            for (int j = 0; j < 4; ++j) v[j] = fsigmoid(v[j]);
            *(u32x2*)(rp + bj * 128 + n * 16) = pack4_bf16(v); } }
  }
};
template <int SECOND> struct EpiMergeF {
  static constexpr bool PERM = false, AFTER_DRAIN = false;
  const bf16_t* G; float* T1; bf16_t* T;
  __device__ __forceinline__ void operator()(const f32x4 (&acc)[2][2][4][2], const Unit& u, int wr, int wc, int fr, int fq) const {
    const size_t o0 = (size_t)(u.pm * 256 + wr * 64 + fr) * 1024 + u.pn * 256 + wc * 32 + 4 * fq;
#pragma unroll
    for (int ai = 0; ai < 2; ++ai)
#pragma unroll
      for (int m = 0; m < 4; ++m)
#pragma unroll
        for (int bj = 0; bj < 2; ++bj)
#pragma unroll
          for (int n = 0; n < 2; ++n) { const size_t o = o0 + (size_t)(ai * 128 + m * 16) * 1024 + bj * 128 + n * 16;
            const f32x4 g = unpack4_bf16(*(const u32x2*)(G + o));
            if (SECOND) { const f32x4 t1 = *(const f32x4*)(T1 + o); *(u32x2*)(T + o) = pack4_bf16(t1 + g * acc[ai][bj][m][n]); }
            else *(f32x4*)(T1 + o) = g * acc[ai][bj][m][n]; }
  }
};
struct EpiR1F {
  static constexpr bool PERM = false, AFTER_DRAIN = false;
  const float* x; const float* mod; float* R1;
  __device__ __forceinline__ void operator()(const f32x4 (&acc)[2][2][4][2], const Unit& u, int wr, int wc, int fr, int fq) const {
    const int col0 = u.pn * 256 + wc * 32 + 4 * fq; const int row0 = u.pm * 256 + wr * 64 + fr;
    const float* g1 = mod + (row0 >> 13) * 6144 + 2048 + col0;
    f32x4 gv[2][2];
#pragma unroll
    for (int bj = 0; bj < 2; ++bj)
#pragma unroll
      for (int n = 0; n < 2; ++n) gv[bj][n] = *(const f32x4*)(g1 + bj * 128 + n * 16);
#pragma unroll
    for (int ai = 0; ai < 2; ++ai)
#pragma unroll
      for (int m = 0; m < 4; ++m)
#pragma unroll
        for (int bj = 0; bj < 2; ++bj)
#pragma unroll
          for (int n = 0; n < 2; ++n) { const size_t o = (size_t)(row0 + ai * 128 + m * 16) * 1024 + col0 + bj * 128 + n * 16;
            const f32x4 xv = *(const f32x4*)(x + o);
            *(f32x4*)(R1 + o) = xv * ALPHA + gv[bj][n] * acc[ai][bj][m][n]; }
  }
};
}

namespace pg8 {
template <class Epi, class Sched>
__device__ __forceinline__ void gemm_phase_x(PG8_LAS unsigned char* lds, const bf16_t* Abase, const int K, const Sched& S, const Epi& E) {
    const int tid = threadIdx.x, wid = __builtin_amdgcn_readfirstlane(tid >> 6), lane = tid & 63, wr = wid >> 2, wc = wid & 3, fr = lane & 15, fq = lane >> 4;
    const int nt = K / BK;
    int Rr[2], Cc[2]; unsigned voffB[2];
#pragma unroll
    for (int i = 0; i < 2; ++i) { stage_rc(tid * 16 + i * 8192, Rr[i], Cc[i]); voffB[i] = (unsigned)(Rr[i] * K + Cc[i]) * 2u; }
    const size_t kstep = (size_t)(BK * 2);
    const size_t hstep = (size_t)HALF * K * 2;
    const unsigned ldsw = (unsigned)wid * 1024u;
    const int aoff = lds_byte(wr * 64 + fr, fq * 8), boff = lds_byte(wc * 32 + fr, fq * 8);
#define PG8_SA(b, h) (((b) * 2 + (h)) * HTB)
#define PG8_SB(b, h) ((4 + (b) * 2 + (h)) * HTB)
#define PG8_STAGE(bufoff, gbase, voff) do { _Pragma("unroll") for (int _i = 0; _i < 2; ++_i) \
        __builtin_amdgcn_global_load_lds((const unsigned*)((const char*)(gbase) + (voff)[_i]), (PG8_LAS unsigned*)(lds + (bufoff) + ldsw + _i * 8192), 16, 0, 0); } while (0)
#define PG8_LDA(dst, b, h) do { _Pragma("unroll") for (int m = 0; m < 4; ++m) _Pragma("unroll") for (int k = 0; k < 2; ++k) dst[m][k] = *(const PG8_LAS bf16x8*)(lds + PG8_SA(b, h) + aoff + m * 2048 + k * 1024); } while (0)
#define PG8_LDB(dst, b, h) do { _Pragma("unroll") for (int n = 0; n < 2; ++n) _Pragma("unroll") for (int k = 0; k < 2; ++k) dst[n][k] = *(const PG8_LAS bf16x8*)(lds + PG8_SB(b, h) + boff + n * 2048 + k * 1024); } while (0)
#define PG8_MMA(ai, bj, At, Bt) do { __builtin_amdgcn_s_setprio(1); _Pragma("unroll") for (int m = 0; m < 4; ++m) _Pragma("unroll") for (int n = 0; n < 2; ++n) _Pragma("unroll") for (int k = 0; k < 2; ++k) \
        acc[ai][bj][m][n] = __builtin_amdgcn_mfma_f32_16x16x32_bf16(Bt[n][k], At[m][k], acc[ai][bj][m][n], 0, 0, 0); __builtin_amdgcn_s_setprio(0); } while (0)
#define PG8_WAIT_V(n) asm volatile("s_waitcnt vmcnt(" #n ")" ::: "memory")
#define PG8_WAIT_L(n) asm volatile("s_waitcnt lgkmcnt(" #n ")" ::: "memory")
#define PG8_BAR __builtin_amdgcn_s_barrier()
#define PG8_SCHED __builtin_amdgcn_sched_barrier(0)
#define PG8_AOFF(dst, u) do { _Pragma("unroll") for (int _h = 0; _h < 2; ++_h) _Pragma("unroll") for (int _i = 0; _i < 2; ++_i) dst[_h][_i] = S.a_off(u, _h * HALF + Rr[_i]) + (unsigned)Cc[_i] * 2u; } while (0)
    Unit cur, nxt; int ui = 0;
    if (!S.next(0, cur)) return;
    f32x4 acc[2][2][4][2];
#pragma unroll
    for (int a = 0; a < 2; ++a)
#pragma unroll
        for (int b = 0; b < 2; ++b)
#pragma unroll
            for (int m = 0; m < 4; ++m)
#pragma unroll
                for (int n = 0; n < 2; ++n) acc[a][b][m][n] = (f32x4){0.f, 0.f, 0.f, 0.f};
    bf16x8 At[4][2], B0[2][2], B1[2][2];
    unsigned offA[2][2], offN[2][2];
    PG8_AOFF(offA, cur);
    const char* const Ab = (const char*)Abase;
    const char* cB = S.b_ptr(cur);
    PG8_STAGE(PG8_SB(0, 0), cB, voffB); PG8_STAGE(PG8_SB(0, 1), cB + hstep, voffB); PG8_STAGE(PG8_SA(0, 0), Ab, offA[0]); PG8_STAGE(PG8_SA(0, 1), Ab, offA[1]);
    if (wr == 1) PG8_BAR;
    PG8_WAIT_V(2); PG8_BAR;
    PG8_STAGE(PG8_SB(1, 0), cB + kstep, voffB); PG8_STAGE(PG8_SA(1, 0), Ab + kstep, offA[0]); PG8_STAGE(PG8_SB(1, 1), cB + hstep + kstep, voffB);
    PG8_WAIT_V(6); PG8_BAR;
    for (;;) {
        const bool has_next = S.next(ui + 1, nxt);
        const char* nB = cB;
#pragma unroll
        for (int h = 0; h < 2; ++h)
#pragma unroll
            for (int i = 0; i < 2; ++i) offN[h][i] = offA[h][i];
        if (has_next) { nB = S.b_ptr(nxt); PG8_AOFF(offN, nxt); }
        for (int t = 0; t < nt; t += 2) {
            const bool last = (t == nt - 2);
            const char* a1 = Ab + (size_t)(t + 1) * kstep;
            const char* a2 = last ? Ab : Ab + (size_t)(t + 2) * kstep; const char* b2 = last ? nB : cB + (size_t)(t + 2) * kstep;
            const char* a3 = a2 + kstep; const char* b3 = b2 + kstep;
            unsigned o2[2][2];
#pragma unroll
            for (int h = 0; h < 2; ++h)
#pragma unroll
                for (int i = 0; i < 2; ++i) o2[h][i] = last ? offN[h][i] : offA[h][i];
            PG8_LDB(B0, 0, 0); PG8_LDB(B1, 0, 1); PG8_SCHED; PG8_LDA(At, 0, 0); PG8_STAGE(PG8_SA(1, 1), a1, offA[1]);
            PG8_WAIT_V(8); PG8_WAIT_L(0); PG8_BAR; PG8_MMA(0, 0, At, B0); PG8_MMA(0, 1, At, B1); PG8_BAR; PG8_SCHED;
            PG8_LDA(At, 0, 1); PG8_STAGE(PG8_SB(0, 0), b2, voffB); PG8_STAGE(PG8_SB(0, 1), b2 + hstep, voffB); PG8_STAGE(PG8_SA(0, 0), a2, o2[0]);
            PG8_WAIT_V(8); PG8_WAIT_L(0); PG8_BAR; PG8_MMA(1, 0, At, B0); PG8_MMA(1, 1, At, B1); PG8_BAR; PG8_SCHED;
            PG8_LDB(B0, 1, 0); PG8_LDB(B1, 1, 1); PG8_SCHED; PG8_LDA(At, 1, 0); PG8_STAGE(PG8_SA(0, 1), a2, o2[1]);
            PG8_WAIT_V(8); PG8_WAIT_L(0); PG8_BAR; PG8_MMA(0, 0, At, B0); PG8_MMA(0, 1, At, B1); PG8_BAR; PG8_SCHED;
            PG8_LDA(At, 1, 1); PG8_STAGE(PG8_SB(1, 0), b3, voffB); PG8_STAGE(PG8_SB(1, 1), b3 + hstep, voffB); PG8_STAGE(PG8_SA(1, 0), a3, o2[0]);
            PG8_WAIT_V(8); PG8_WAIT_L(0); PG8_BAR; PG8_MMA(1, 0, At, B0); PG8_MMA(1, 1, At, B1); PG8_BAR; PG8_SCHED;
        }
        if (wr == 0) PG8_BAR;
        E(acc, cur, wr, wc, fr, fq);
        if (!has_next) break;
#pragma unroll
        for (int a = 0; a < 2; ++a)
#pragma unroll
            for (int b = 0; b < 2; ++b)
#pragma unroll
                for (int m = 0; m < 4; ++m)
#pragma unroll
                    for (int n = 0; n < 2; ++n) acc[a][b][m][n] = (f32x4){0.f, 0.f, 0.f, 0.f};
        cur = nxt; cB = nB; ++ui;
#pragma unroll
        for (int h = 0; h < 2; ++h)
#pragma unroll
            for (int i = 0; i < 2; ++i) offA[h][i] = offN[h][i];
        if (wr == 1) PG8_BAR;
    }
    PG8_WAIT_V(0);
    PG8_BAR;
#undef PG8_SA
#undef PG8_SB
#undef PG8_STAGE
#undef PG8_LDA
#undef PG8_LDB
#undef PG8_MMA
#undef PG8_WAIT_V
#undef PG8_WAIT_L
#undef PG8_BAR
#undef PG8_SCHED
#undef PG8_AOFF
}
}

namespace moe {
__device__ __forceinline__ void build_tiles(const int* __restrict__ cnt, int* tb, int* te) {
  const int tid = threadIdx.x;
  if (tid < 64) {
    const int nt = (cnt[tid] + 255) >> 8; int x = nt;
#pragma unroll
    for (int d = 1; d < 64; d <<= 1) { const int t = __shfl_up(x, d); if (tid >= d) x += t; }
    tb[tid] = x - nt;
    if (tid == 63) { tb[64] = x; tb[65] = x + 64; }
  }
  __syncthreads();
  if (tid < 65) for (int t = tb[tid]; t < tb[tid + 1]; ++t) te[t] = tid;
  __syncthreads();
}
using pg8::Unit; using pg8::f32x4; using pg8::u32x2;
struct OrderGU {
  const int* cnt; const int* LIST; const bf16_t* WGU; const int* tb; const int* te; int G, c, nunits;
  __device__ __forceinline__ bool next(int i, Unit& u) const { const int L = i * G + c; if (L >= nunits) return false; u.pm = L >> 1; u.pn = L & 1; return true; }
  __device__ __forceinline__ unsigned a_off(const Unit& u, int r) const {
    const int e = te[u.pm]; int row;
    if (e == 64) row = (u.pm - tb[64]) * 256 + r;
    else { const int pos = (u.pm - tb[e]) * 256 + r; row = pos < cnt[e] ? LIST[e * 16384 + pos] : 0; }
    return (unsigned)row * 2048u;
  }
  __device__ __forceinline__ const char* b_ptr(const Unit& u) const { return (const char*)(WGU + ((size_t)te[u.pm] * 512 + u.pn * 256) * 1024); }
};
struct EpiAct {
  const int* cnt; const float* LISTW; const int* tb; const int* te; bf16_t* ACT;
  __device__ __forceinline__ void operator()(const f32x4 (&acc)[2][2][4][2], const Unit& u, int wr, int wc, int fr, int fq) const {
    const int e = te[u.pm], lt = u.pm - tb[e], ce = e < 64 ? cnt[e] : 0;
#pragma unroll
    for (int ai = 0; ai < 2; ++ai)
#pragma unroll
      for (int m = 0; m < 4; ++m) {
        const int r = ai * 128 + wr * 64 + m * 16 + fr, pos = lt * 256 + r;
        float w = 1.0f;
        if (e < 64) w = pos < ce ? LISTW[e * 16384 + pos] : 0.f;
        bf16_t* dst = ACT + ((size_t)u.pm * 256 + r) * 256 + u.pn * 128 + wc * 32 + 4 * fq;
#pragma unroll
        for (int n = 0; n < 2; ++n) { const f32x4 g = acc[ai][0][m][n], up = acc[ai][1][m][n]; f32x4 a;
#pragma unroll
          for (int j = 0; j < 4; ++j) a[j] = g[j] * pg8::fsigmoid(g[j]) * up[j] * w;
          *(u32x2*)(dst + n * 16) = pg8::pack4_bf16(a); }
      }
  }
};
struct OrderDN {
  const bf16_t* WD; const int* te; int G, c, t0, nrt, sh0, nunits;
  __device__ __forceinline__ bool next(int i, Unit& u) const { const int L = i * G + c; if (L >= nunits) return false; const int t = L >> 2; u.pn = L & 3; u.pm = t < nrt ? t0 + t : sh0 + (t - nrt); return true; }
  __device__ __forceinline__ unsigned a_off(const Unit& u, int r) const { return (unsigned)(u.pm * 256 + r) * 512u; }
  __device__ __forceinline__ const char* b_ptr(const Unit& u) const { return (const char*)(WD + ((size_t)te[u.pm] * 1024 + u.pn * 256) * 256); }
};
struct EpiDown {
  const int* tb; const int* te; bf16_t* Y; bf16_t* Y2; int ybase;
  __device__ __forceinline__ void operator()(const f32x4 (&acc)[2][2][4][2], const Unit& u, int wr, int wc, int fr, int fq) const {
    const int e = te[u.pm];
    bf16_t* base = (e == 64 ? Y2 + (size_t)(u.pm - tb[64]) * 256 * 1024 : Y + (size_t)(u.pm - ybase) * 256 * 1024) + (size_t)(wr * 64 + fr) * 1024 + u.pn * 256 + wc * 32 + 4 * fq;
#pragma unroll
    for (int ai = 0; ai < 2; ++ai)
#pragma unroll
      for (int m = 0; m < 4; ++m) { bf16_t* rp = base + (size_t)(ai * 128 + m * 16) * 1024;
#pragma unroll
        for (int bj = 0; bj < 2; ++bj)
#pragma unroll
          for (int n = 0; n < 2; ++n) *(u32x2*)(rp + bj * 128 + n * 16) = pg8::pack4_bf16(acc[ai][bj][m][n]); }
  }
};
__device__ __forceinline__ void gather_rows(const int* __restrict__ TOPE, const int* __restrict__ TOPP, const int* tb, const bf16_t* __restrict__ Y, int ybase, int lo, int hi, int t, int lane, float (&s)[16]) {
#pragma unroll 1
  for (int kk = 0; kk < 8; ++kk) {
    const int e = TOPE[t * 8 + kk], pos = TOPP[t * 8 + kk], gt = tb[e] + (pos >> 8);
    if (gt >= lo && gt < hi) {
      const bf16_t* yr = Y + ((size_t)(gt - ybase) * 256 + (pos & 255)) * 1024 + lane * 4;
#pragma unroll
      for (int j = 0; j < 4; ++j) { const f32x4 v = pg8::unpack4_bf16(*(const u32x2*)(yr + j * 256)); s[4 * j] += v[0]; s[4 * j + 1] += v[1]; s[4 * j + 2] += v[2]; s[4 * j + 3] += v[3]; }
    }
  }
}
}

namespace fastna {
typedef short bf16x8 __attribute__((ext_vector_type(8)));
typedef float f32x4 __attribute__((ext_vector_type(4)));
typedef unsigned u32x2 __attribute__((ext_vector_type(2)));
typedef unsigned u32x4 __attribute__((ext_vector_type(4)));
__device__ __forceinline__ int clampi(int v, int lo, int hi) { return v < lo ? lo : (v > hi ? hi : v); }
__device__ __forceinline__ void na_wave(const bf16_t* __restrict__ QR, const bf16_t* __restrict__ QN, const bf16_t* __restrict__ KN, const bf16_t* __restrict__ VT, const float* __restrict__ rpb,
                                        bf16_t* __restrict__ YN, int hn, int r, int g, int lane) {
  const int q = lane & 15, gq = lane >> 4;
  const int s0 = r * 64 + 16 * g;
  const int row_start = clampi(r - 4, 0, 120), blk_start = clampi(16 * g - 8, 0, 32);
  const int qcol = 16 * g + q, col_start = clampi(qcol - 8, 0, 48);
  const size_t qo = (size_t)(s0 + q) * 1024 + hn * 64 + 8 * gq;
  bf16x8 qf[2];
  qf[0] = *(const bf16x8*)(QR + qo); qf[1] = *(const bf16x8*)(QR + qo + 32);
  f32x4 sc[16];
  f32x4 o[4];
#pragma unroll
  for (int mt = 0; mt < 4; ++mt) o[mt] = (f32x4){0.f, 0.f, 0.f, 0.f};
  const bf16_t* vrow = VT + (size_t)(hn * 64 + q) * PB_ROWS + 4 * gq;
  float m = -3.0e38f;
#pragma unroll
  for (int kr = 0; kr < 8; ++kr) {
    const int krow = row_start + kr;
    const float* bp = rpb + (hn * 15 + (krow - r + 7)) * 31;
#pragma unroll
    for (int half = 0; half < 2; ++half) {
      const size_t ko = (size_t)(krow * 64 + blk_start + 16 * half + q) * 1024 + hn * 64 + 8 * gq;
      const bf16x8 k0 = *(const bf16x8*)(KN + ko), k1 = *(const bf16x8*)(KN + ko + 32);
      f32x4 a = {0.f, 0.f, 0.f, 0.f};
      a = __builtin_amdgcn_mfma_f32_16x16x32_bf16(k0, qf[0], a, 0, 0, 0);
      a = __builtin_amdgcn_mfma_f32_16x16x32_bf16(k1, qf[1], a, 0, 0, 0);
#pragma unroll
      for (int j = 0; j < 4; ++j) {
        const int kcol = blk_start + 16 * half + 4 * gq + j;
        const bool valid = (kcol >= col_start) && (kcol < col_start + 16);
        const int dc = clampi(kcol - qcol + 15, 0, 30);
        const float v = valid ? a[j] + bp[dc] : -1.0e30f;
        a[j] = v; m = fmaxf(m, v);
      }
      sc[kr * 2 + half] = a;
    }
  }
  m = fmaxf(m, __shfl_xor(m, 16)); m = fmaxf(m, __shfl_xor(m, 32));
  float l = 0.f;
#pragma unroll
  for (int p = 0; p < 8; ++p) {
    f32x4 p0 = sc[2 * p], p1 = sc[2 * p + 1];
#pragma unroll
    for (int j = 0; j < 4; ++j) { p0[j] = __expf(p0[j] - m); p1[j] = __expf(p1[j] - m); l += p0[j] + p1[j]; }
    u32x4 pw; pw.x = pg8::cvt_pk_bf16(p0[0], p0[1]); pw.y = pg8::cvt_pk_bf16(p0[2], p0[3]); pw.z = pg8::cvt_pk_bf16(p1[0], p1[1]); pw.w = pg8::cvt_pk_bf16(p1[2], p1[3]);
    const bf16x8 pf = __builtin_bit_cast(bf16x8, pw);
    const int tok = (row_start + p) * 64 + blk_start;
#pragma unroll
    for (int mt = 0; mt < 4; ++mt) {
      const bf16_t* vp = vrow + (size_t)(16 * mt) * PB_ROWS + tok;
      const u32x2 v0 = *(const u32x2*)(vp), v1 = *(const u32x2*)(vp + 16);
      u32x4 vw; vw.x = v0.x; vw.y = v0.y; vw.z = v1.x; vw.w = v1.y;
      o[mt] = __builtin_amdgcn_mfma_f32_16x16x32_bf16(__builtin_bit_cast(bf16x8, vw), pf, o[mt], 0, 0, 0);
    }
  }
  qf[0] = *(const bf16x8*)(QN + qo); qf[1] = *(const bf16x8*)(QN + qo + 32);
  float m2 = -3.0e38f;
#pragma unroll
  for (int t = 0; t < 16; ++t) {
    const size_t ko = (size_t)(SEQ + 16 * t + q) * 1024 + hn * 64 + 8 * gq;
    const bf16x8 k0 = *(const bf16x8*)(KN + ko), k1 = *(const bf16x8*)(KN + ko + 32);
    f32x4 a = {0.f, 0.f, 0.f, 0.f};
    a = __builtin_amdgcn_mfma_f32_16x16x32_bf16(k0, qf[0], a, 0, 0, 0);
    a = __builtin_amdgcn_mfma_f32_16x16x32_bf16(k1, qf[1], a, 0, 0, 0);
    m2 = fmaxf(m2, fmaxf(fmaxf(a[0], a[1]), fmaxf(a[2], a[3])));
    sc[t] = a;
  }
  m2 = fmaxf(m2, __shfl_xor(m2, 16)); m2 = fmaxf(m2, __shfl_xor(m2, 32));
  {
    const float mn = fmaxf(m, m2), f = __expf(m - mn);
    l *= f;
#pragma unroll
    for (int mt = 0; mt < 4; ++mt) o[mt] = o[mt] * f;
    m = mn;
  }
#pragma unroll
  for (int p = 0; p < 8; ++p) {
    f32x4 p0 = sc[2 * p], p1 = sc[2 * p + 1];
#pragma unroll
    for (int j = 0; j < 4; ++j) { p0[j] = __expf(p0[j] - m); p1[j] = __expf(p1[j] - m); l += p0[j] + p1[j]; }
    u32x4 pw; pw.x = pg8::cvt_pk_bf16(p0[0], p0[1]); pw.y = pg8::cvt_pk_bf16(p0[2], p0[3]); pw.z = pg8::cvt_pk_bf16(p1[0], p1[1]); pw.w = pg8::cvt_pk_bf16(p1[2], p1[3]);
    const bf16x8 pf = __builtin_bit_cast(bf16x8, pw);
    const int tok = SEQ + 32 * p;
#pragma unroll
    for (int mt = 0; mt < 4; ++mt) {
      const bf16_t* vp = vrow + (size_t)(16 * mt) * PB_ROWS + tok;
      const u32x2 v0 = *(const u32x2*)(vp), v1 = *(const u32x2*)(vp + 16);
      u32x4 vw; vw.x = v0.x; vw.y = v0.y; vw.z = v1.x; vw.w = v1.y;
      o[mt] = __builtin_amdgcn_mfma_f32_16x16x32_bf16(__builtin_bit_cast(bf16x8, vw), pf, o[mt], 0, 0, 0);
    }
  }
  l += __shfl_xor(l, 16); l += __shfl_xor(l, 32);
  const float il = 1.0f / l;
  bf16_t* yo = YN + (size_t)(s0 + q) * 1024 + hn * 64 + 4 * gq;
#pragma unroll
  for (int mt = 0; mt < 4; ++mt) {
    u32x2 w; w.x = pg8::cvt_pk_bf16(o[mt][0] * il, o[mt][1] * il); w.y = pg8::cvt_pk_bf16(o[mt][2] * il, o[mt][3] * il);
    *(u32x2*)(yo + 16 * mt) = w;
  }
}
}

namespace fasthg {
typedef short bf16x8 __attribute__((ext_vector_type(8)));
typedef float f32x4 __attribute__((ext_vector_type(4)));
typedef unsigned u32x2 __attribute__((ext_vector_type(2)));
typedef unsigned u32x4 __attribute__((ext_vector_type(4)));
typedef _Float16 f16x8 __attribute__((ext_vector_type(8)));
constexpr int KD_LD = 72, QA_LD = 136;
constexpr size_t UT_UNIT = 128 * 128;
__device__ __forceinline__ float lane_prefix(float x, int lane) {
#pragma unroll
  for (int d = 1; d < 64; d <<= 1) { const float t = __shfl_up(x, d); if (lane >= d) x += t; }
  return x;
}
__device__ __forceinline__ int chunk_row0(int dir, int n) {
  if (n < 4) return SEQ + 64 * (dir ? 3 - n : n);
  return 64 * (dir ? 131 - n : n - 4);
}
__device__ __forceinline__ void hgA_unit(const bf16_t* __restrict__ LF, const bf16_t* __restrict__ LB, const bf16_t* __restrict__ IT, bf16_t* __restrict__ UT, float* __restrict__ DEC,
                                         int unit, bf16_t* kd, int wid, int lane) {
  const int n = unit % 132, hd = unit / 132, dir = hd & 1, h = hd >> 1;
  const int rb0 = chunk_row0(dir, n);
  const bf16_t* src = (dir ? LB : LF) + (size_t)(rb0 + lane) * 1024 + h * 128 + 16 * wid;
  const f16x8 l0 = *(const f16x8*)src, l1 = *(const f16x8*)(src + 8);
#pragma unroll
  for (int c = 0; c < 16; ++c) {
    const float lf = (float)(c < 8 ? l0[c & 7] : l1[c & 7]);
    const float P = lane_prefix(lf, lane), tot = __shfl(P, 63);
    const float e = dir ? (P - lf) : (tot - P);
    const float kdec = (1.0f - __expf(lf)) * __expf(e);
    kd[(16 * wid + c) * KD_LD + lane] = (bf16_t)(pg8::cvt_pk_bf16(kdec, 0.f) & 0xffffu);
    if (lane == 0) DEC[(size_t)unit * 128 + 16 * wid + c] = __expf(tot);
  }
  __syncthreads();
  const int q = lane & 15, g = lane >> 4;
  const bf16x8 a0 = *(const bf16x8*)(kd + (16 * wid + q) * KD_LD + 8 * g), a1 = *(const bf16x8*)(kd + (16 * wid + q) * KD_LD + 32 + 8 * g);
  bf16_t* uo = UT + (size_t)unit * UT_UNIT + 16 * wid + 4 * g;
#pragma unroll
  for (int nt = 0; nt < 8; ++nt) {
    const int vcol = 16 * nt + q;
    const bf16_t* vp = IT + (size_t)(h * 128 + vcol) * PB_ROWS + rb0 + 8 * g;
    const bf16x8 b0 = *(const bf16x8*)vp, b1 = *(const bf16x8*)(vp + 32);
    f32x4 acc = {0.f, 0.f, 0.f, 0.f};
    acc = __builtin_amdgcn_mfma_f32_16x16x32_bf16(a0, b0, acc, 0, 0, 0);
    acc = __builtin_amdgcn_mfma_f32_16x16x32_bf16(a1, b1, acc, 0, 0, 0);
    u32x2 w; w.x = pg8::cvt_pk_bf16(acc[0], acc[1]); w.y = pg8::cvt_pk_bf16(acc[2], acc[3]);
    *(u32x2*)(uo + (size_t)vcol * 128) = w;
  }
  __syncthreads();
}
__device__ __forceinline__ void hg_scan(bf16_t* __restrict__ UT, const float* __restrict__ DEC, int gtid, int gsz) {
  for (int id = gtid; id < 16 * 8192; id += gsz) {
    const int chain = id >> 13, pr = id & 8191;
    unsigned* up = (unsigned*)(UT + (size_t)chain * 132 * UT_UNIT + 2 * pr);
    const float* dp = DEC + (size_t)chain * 132 * 128 + ((2 * pr) & 127);
    float s0 = 0.f, s1 = 0.f;
#pragma unroll 6
    for (int n = 0; n < 132; ++n) {
      const unsigned u = up[(size_t)n * (UT_UNIT / 2)];
      const float2 d = *(const float2*)(dp + n * 128);
      up[(size_t)n * (UT_UNIT / 2)] = pg8::cvt_pk_bf16(s0, s1);
      s0 = d.x * s0 + __uint_as_float(u << 16); s1 = d.y * s1 + __uint_as_float(u & 0xffff0000u);
    }
  }
}
__device__ __forceinline__ void hgC_unit(const bf16_t* __restrict__ Q, const bf16_t* __restrict__ LF, const bf16_t* __restrict__ LB, const bf16_t* __restrict__ IT, const bf16_t* __restrict__ OG,
                                         const bf16_t* __restrict__ UT, const float* __restrict__ gain, bf16_t* __restrict__ YH  , int unit, bf16_t* qa, bf16_t* kb, float* ssq, int wid, int lane) {
  const int h = unit >> 7, m = unit & 127, rb0 = 64 * m;
  const int it = wid & 3, vh = wid >> 2, q = lane & 15, g = lane >> 4;
  f32x4 o[4];
#pragma unroll
  for (int mt = 0; mt < 4; ++mt) o[mt] = (f32x4){0.f, 0.f, 0.f, 0.f};
#pragma unroll 1
  for (int dir = 0; dir < 2; ++dir) {
    {
      const size_t so = (size_t)(rb0 + lane) * 1024 + h * 128 + 16 * wid;
      const bf16_t* src = (dir ? LB : LF) + so;
      const f16x8 l0 = *(const f16x8*)src, l1 = *(const f16x8*)(src + 8);
      const u32x4 q0 = *(const u32x4*)(Q + so), q1 = *(const u32x4*)(Q + so + 8);
      const unsigned qw[8] = {q0.x, q0.y, q0.z, q0.w, q1.x, q1.y, q1.z, q1.w};
      unsigned qaw[8], kbw[8];
#pragma unroll
      for (int c2 = 0; c2 < 8; ++c2) {
        float qav[2], kbv[2];
#pragma unroll
        for (int e = 0; e < 2; ++e) {
          const int c = 2 * c2 + e;
          const float lf = (float)(c < 8 ? l0[c & 7] : l1[c & 7]);
          const float qv = e ? __uint_as_float(qw[c2] & 0xffff0000u) : __uint_as_float(qw[c2] << 16);
          const float P = lane_prefix(lf, lane), tot = __shfl(P, 63);
          const float a = dir ? (tot - P + lf) : P;
          qav[e] = qv * __expf(a); kbv[e] = (1.0f - __expf(lf)) * __expf(-a);
        }
        qaw[c2] = pg8::cvt_pk_bf16(qav[0], qav[1]); kbw[c2] = pg8::cvt_pk_bf16(kbv[0], kbv[1]);
      }
      u32x4* qd = (u32x4*)(qa + lane * QA_LD + 16 * wid); u32x4* kdp = (u32x4*)(kb + lane * QA_LD + 16 * wid);
      qd[0] = (u32x4){qaw[0], qaw[1], qaw[2], qaw[3]}; qd[1] = (u32x4){qaw[4], qaw[5], qaw[6], qaw[7]};
      kdp[0] = (u32x4){kbw[0], kbw[1], kbw[2], kbw[3]}; kdp[1] = (u32x4){kbw[4], kbw[5], kbw[6], kbw[7]};
    }
    __syncthreads();
    bf16x8 qf[4];
#pragma unroll
    for (int ks = 0; ks < 4; ++ks) qf[ks] = *(const bf16x8*)(qa + (16 * it + q) * QA_LD + 32 * ks + 8 * g);
    f32x4 pt[4];
#pragma unroll
    for (int jt = 0; jt < 4; ++jt) {
      pt[jt] = (f32x4){0.f, 0.f, 0.f, 0.f};
      const bool need = dir ? (jt >= it) : (jt <= it);
      if (need) {
        f32x4 acc = {0.f, 0.f, 0.f, 0.f};
#pragma unroll
        for (int ks = 0; ks < 4; ++ks) { const bf16x8 af = *(const bf16x8*)(kb + (16 * jt + q) * QA_LD + 32 * ks + 8 * g); acc = __builtin_amdgcn_mfma_f32_16x16x32_bf16(af, qf[ks], acc, 0, 0, 0); }
#pragma unroll
        for (int r = 0; r < 4; ++r) { const int j = 16 * jt + 4 * g + r, i = 16 * it + q; const bool keep = dir ? (j >= i) : (j <= i); pt[jt][r] = keep ? acc[r] : 0.f; }
      }
    }
#pragma unroll
    for (int p = 0; p < 2; ++p) {
      const bool need = dir ? (2 * p + 1 >= it) : (2 * p <= it);
      if (need) {
        u32x4 pw; pw.x = pg8::cvt_pk_bf16(pt[2 * p][0], pt[2 * p][1]); pw.y = pg8::cvt_pk_bf16(pt[2 * p][2], pt[2 * p][3]); pw.z = pg8::cvt_pk_bf16(pt[2 * p + 1][0], pt[2 * p + 1][1]); pw.w = pg8::cvt_pk_bf16(pt[2 * p + 1][2], pt[2 * p + 1][3]);
        const bf16x8 pf = __builtin_bit_cast(bf16x8, pw);
#pragma unroll
        for (int mt = 0; mt < 4; ++mt) {
          const bf16_t* vp = IT + (size_t)(h * 128 + 64 * vh + 16 * mt + q) * PB_ROWS + rb0 + 32 * p + 4 * g;
          const u32x2 v0 = *(const u32x2*)vp, v1 = *(const u32x2*)(vp + 16);
          u32x4 vw; vw.x = v0.x; vw.y = v0.y; vw.z = v1.x; vw.w = v1.y;
          o[mt] = __builtin_amdgcn_mfma_f32_16x16x32_bf16(__builtin_bit_cast(bf16x8, vw), pf, o[mt], 0, 0, 0);
        }
      }
    }
    {
      const bf16_t* st = UT + (size_t)((h * 2 + dir) * 132 + (dir ? 131 - m : 4 + m)) * UT_UNIT;
#pragma unroll
      for (int mt = 0; mt < 4; ++mt)
#pragma unroll
        for (int ks = 0; ks < 4; ++ks) { const bf16x8 af = *(const bf16x8*)(st + (size_t)(64 * vh + 16 * mt + q) * 128 + 32 * ks + 8 * g); o[mt] = __builtin_amdgcn_mfma_f32_16x16x32_bf16(af, qf[ks], o[mt], 0, 0, 0); }
    }
    __syncthreads();
  }
  float ss = 0.f;
#pragma unroll
  for (int mt = 0; mt < 4; ++mt) ss += o[mt][0] * o[mt][0] + o[mt][1] * o[mt][1] + o[mt][2] * o[mt][2] + o[mt][3] * o[mt][3];
  ss += __shfl_xor(ss, 16); ss += __shfl_xor(ss, 32);
  if (lane < 16) ssq[vh * 64 + 16 * it + lane] = ss;
  __syncthreads();
  const float rr = rsqrtf((ssq[16 * it + q] + ssq[64 + 16 * it + q]) * (1.0f / 128.0f) + LN_EPS);
  const int rb = rb0 + 16 * it + q;
#pragma unroll
  for (int mt = 0; mt < 4; ++mt) {
    const int col = h * 128 + 64 * vh + 16 * mt + 4 * g;
    const f32x4 gg = *(const f32x4*)(gain + col);
    const f32x4 og = pg8::unpack4_bf16(*(const u32x2*)(OG + (size_t)rb * 1024 + col));
    const f32x4 y = o[mt] * rr * gg * og;
    *(u32x2*)(YH + (size_t)rb * 1024 + col) = pg8::pack4_bf16(y);
  }
  __syncthreads();
}
}

#ifndef FAST_S2
#define FAST_S2 1
#endif
constexpr int LDS_BYTES = 147456;
struct MP {
  const float* in[26]; float* out; unsigned char* ws;
};
#define WSP(T, off) ((T*)(p.ws + (off)))
template <int PH> __global__ void __launch_bounds__(512, 2) k_phase(MP p, int b) {
  extern __shared__ __attribute__((aligned(16))) unsigned char lds_raw[];
  PG8_LAS unsigned char* lds = (PG8_LAS unsigned char*)lds_raw;
  const int G = gridDim.x, c = blockIdx.x;
  if constexpr (PH == 2) {
    pg8::Gemm g{WSP(bf16_t, OFF_H), WSP(bf16_t, OFF_WIN), NROW, 8192, 1024};
    pg8::OrderS2 S; S.init(b, G, c);
    pg8::EpiS2F E{WSP(bf16_t, OFF_Q), WSP(bf16_t, OFF_I), WSP(bf16_t, OFF_OG), WSP(bf16_t, OFF_QR), WSP(bf16_t, OFF_QN), WSP(bf16_t, OFF_KN), WSP(bf16_t, OFF_V), WSP(bf16_t, OFF_LF), WSP(bf16_t, OFF_LB),
                  WSP(float, OFF_LBF), WSP(float, OFF_LBB), WSP(float, OFF_ROPE), b};
    pg8::gemm_phase<pg8::EpiS2F, pg8::OrderS2, true, true>(lds, g, S, E);
  }
  if constexpr (PH == 3) {
    const int wid = __builtin_amdgcn_readfirstlane(threadIdx.x >> 6), lane = threadIdx.x & 63;
    for (int wu = c; wu < 1024; wu += G) {
      const int idx = wu * 8 + wid, hn = idx >> 9, r = (idx >> 2) & 127, g = idx & 3;
      fastna::na_wave(WSP(bf16_t, OFF_QR), WSP(bf16_t, OFF_QN), WSP(bf16_t, OFF_KN), WSP(bf16_t, OFF_V), p.in[10], (bf16_t*)p.out + (size_t)(NTOK + b * SEQ) * 1024, hn, r, g, lane);
    }
  }
  if constexpr (PH == 4) {
    const int wid = __builtin_amdgcn_readfirstlane(threadIdx.x >> 6), lane = threadIdx.x & 63;
    for (int u = c; u < 16 * 132; u += G)
      fasthg::hgA_unit(WSP(bf16_t, OFF_LF), WSP(bf16_t, OFF_LB), WSP(bf16_t, OFF_I), WSP(bf16_t, OFF_E), WSP(float, OFF_E + 66 * MiB), u, (bf16_t*)lds_raw, wid, lane);
  }
  if constexpr (PH == 5) fasthg::hg_scan(WSP(bf16_t, OFF_E), WSP(float, OFF_E + 66 * MiB), c * 512 + threadIdx.x, G * 512);
  if constexpr (PH == 10) {
    const int wid = __builtin_amdgcn_readfirstlane(threadIdx.x >> 6), lane = threadIdx.x & 63;
    bf16_t* qa = (bf16_t*)lds_raw; bf16_t* kbp = qa + 64 * fasthg::QA_LD; float* ssq = (float*)(kbp + 64 * fasthg::QA_LD);
    for (int u = c; u < 8 * 128; u += G)
      fasthg::hgC_unit(WSP(bf16_t, OFF_Q), WSP(bf16_t, OFF_LF), WSP(bf16_t, OFF_LB), WSP(bf16_t, OFF_I), WSP(bf16_t, OFF_OG), WSP(bf16_t, OFF_E), p.in[9], (bf16_t*)p.out + (size_t)b * SEQ * 1024, u, qa, kbp, ssq, wid, lane);
  }
  if constexpr (PH == 11 || PH == 12 || PH == 13 || PH == 14 || PH == 15) {
    int* tb = (int*)(lds_raw + 131072); int* te = tb + 128;
    moe::build_tiles(WSP(int, OFF_CNT), tb, te);
    const int NT = tb[64];
    if constexpr (PH == 11) {
      moe::OrderGU S{WSP(int, OFF_CNT), WSP(int, OFF_LIST), WSP(bf16_t, OFF_WGU), tb, te, G, c, (NT + 64) * 2};
      moe::EpiAct E{WSP(int, OFF_CNT), WSP(float, OFF_LISTW), tb, te, WSP(bf16_t, OFF_ACT)};
      pg8::gemm_phase_x<moe::EpiAct, moe::OrderGU>(lds, WSP(bf16_t, OFF_H2), 1024, S, E);
    }
    if constexpr (PH == 12 || PH == 14) {
      const int t0 = PH == 12 ? 0 : Y_TILES, t1 = PH == 12 ? (NT < Y_TILES ? NT : Y_TILES) : NT, nrt = t1 > t0 ? t1 - t0 : 0, nsh = PH == 12 ? 64 : 0;
      moe::OrderDN S{WSP(bf16_t, OFF_WD), te, G, c, t0, nrt, NT, (nrt + nsh) * 4};
      moe::EpiDown E{tb, te, WSP(bf16_t, OFF_Y), WSP(bf16_t, OFF_H2), t0};
      pg8::gemm_phase_x<moe::EpiDown, moe::OrderDN>(lds, WSP(bf16_t, OFF_ACT), 256, S, E);
    }
    if constexpr (PH == 13) {
      const int wid = threadIdx.x >> 6, lane = threadIdx.x & 63; bf16_t* Y2 = WSP(bf16_t, OFF_H2);
      for (int t = c * 8 + wid; t < NTOK; t += G * 8) {
        float s[16];
#pragma unroll
        for (int j = 0; j < 4; ++j) { const pg8::f32x4 v = pg8::unpack4_bf16(*(const pg8::u32x2*)(Y2 + (size_t)t * 1024 + j * 256 + lane * 4)); s[4 * j] = v[0]; s[4 * j + 1] = v[1]; s[4 * j + 2] = v[2]; s[4 * j + 3] = v[3]; }
        moe::gather_rows(WSP(int, OFF_TOPE), WSP(int, OFF_TOPP), tb, WSP(bf16_t, OFF_Y), 0, 0, Y_TILES, t, lane, s);
#pragma unroll
        for (int j = 0; j < 4; ++j) *(pg8::u32x2*)(Y2 + (size_t)t * 1024 + j * 256 + lane * 4) = pg8::pack4_bf16((pg8::f32x4){s[4 * j], s[4 * j + 1], s[4 * j + 2], s[4 * j + 3]});
      }
    }
    if constexpr (PH == 15) {
      const int wid = threadIdx.x >> 6, lane = threadIdx.x & 63; const bf16_t* Y2 = WSP(bf16_t, OFF_H2);
      const float* mod = WSP(float, OFF_MOD); const float* ln_g = p.in[24]; const float* ln_b = p.in[25];
      for (int t = c * 8 + wid; t < NTOK; t += G * 8) {
        float s[16];
#pragma unroll
        for (int j = 0; j < 4; ++j) { const pg8::f32x4 v = pg8::unpack4_bf16(*(const pg8::u32x2*)(Y2 + (size_t)t * 1024 + j * 256 + lane * 4)); s[4 * j] = v[0]; s[4 * j + 1] = v[1]; s[4 * j + 2] = v[2]; s[4 * j + 3] = v[3]; }
        moe::gather_rows(WSP(int, OFF_TOPE), WSP(int, OFF_TOPP), tb, WSP(bf16_t, OFF_Y), Y_TILES, Y_TILES, 1 << 30, t, lane, s);
        float* xr = p.out + (size_t)t * D; const float* g2 = mod + (t >> 13) * 6144 + 5 * 1024;
        float sum = 0.f;
#pragma unroll
        for (int j = 0; j < 4; ++j) { const int kx = j * 256 + lane * 4; const float4 xv = *(const float4*)(xr + kx), gg = *(const float4*)(g2 + kx);
          s[4 * j] = ALPHA * xv.x + gg.x * s[4 * j]; s[4 * j + 1] = ALPHA * xv.y + gg.y * s[4 * j + 1]; s[4 * j + 2] = ALPHA * xv.z + gg.z * s[4 * j + 2]; s[4 * j + 3] = ALPHA * xv.w + gg.w * s[4 * j + 3];
          sum += s[4 * j] + s[4 * j + 1] + s[4 * j + 2] + s[4 * j + 3]; }
        const float mu = wave_sum(sum) * (1.0f / D); float qv = 0.f;
#pragma unroll
        for (int i = 0; i < 16; ++i) { s[i] -= mu; qv += s[i] * s[i]; }
        const float rstd = rsqrtf(wave_sum(qv) * (1.0f / D) + LN_EPS);
#pragma unroll
        for (int j = 0; j < 4; ++j) { const int kx = j * 256 + lane * 4; const float4 g = *(const float4*)(ln_g + kx), bb = *(const float4*)(ln_b + kx);
          *(float4*)(xr + kx) = make_float4(s[4 * j] * rstd * g.x + bb.x, s[4 * j + 1] * rstd * g.y + bb.y, s[4 * j + 2] * rstd * g.z + bb.z, s[4 * j + 3] * rstd * g.w + bb.w); }
      }
    }
  }
  if constexpr (PH == 6) {
    pg8::Gemm g{WSP(bf16_t, OFF_H), WSP(bf16_t, OFF_WIN) + (size_t)8192 * 1024, NTOK, 2048, 1024};
    pg8::StaticOrder S; S.init(NTOK, 2048, G, c);
    pg8::EpiGateF E{WSP(bf16_t, OFF_GA), WSP(bf16_t, OFF_GB)};
    pg8::gemm_phase<pg8::EpiGateF, pg8::StaticOrder, true, true>(lds, g, S, E);
  }
  if constexpr (PH == 7) {
    pg8::Gemm g{(const bf16_t*)p.out, WSP(bf16_t, OFF_WA), NTOK, 1024, 1024};
    pg8::StaticOrder S; S.init(NTOK, 1024, G, c);
    pg8::EpiMergeF<0> E{WSP(bf16_t, OFF_GA), WSP(float, OFF_T1), WSP(bf16_t, OFF_T)};
    pg8::gemm_phase<pg8::EpiMergeF<0>, pg8::StaticOrder, true, true>(lds, g, S, E);
  }
  if constexpr (PH == 8) {
    pg8::Gemm g{(const bf16_t*)p.out + (size_t)NTOK * 1024, WSP(bf16_t, OFF_WB), NTOK, 1024, 1024};
    pg8::StaticOrder S; S.init(NTOK, 1024, G, c);
    pg8::EpiMergeF<1> E{WSP(bf16_t, OFF_GB), WSP(float, OFF_T1), WSP(bf16_t, OFF_T)};
    pg8::gemm_phase<pg8::EpiMergeF<1>, pg8::StaticOrder, true, true>(lds, g, S, E);
  }
  if constexpr (PH == 9) {
    pg8::Gemm g{WSP(bf16_t, OFF_T), WSP(bf16_t, OFF_WOUT), NTOK, 1024, 1024};
    pg8::StaticOrder S; S.init(NTOK, 1024, G, c);
    pg8::EpiR1F E{p.in[0], WSP(float, OFF_MOD), p.out};
    pg8::gemm_phase<pg8::EpiR1F, pg8::StaticOrder, true, true>(lds, g, S, E);
  }
}
template <int PH> static void launch_phase(const MP& p, int b, hipStream_t stream) {
  static bool attr = false;
  if (!attr) { (void)hipFuncSetAttribute((const void*)k_phase<PH>, hipFuncAttributeMaxDynamicSharedMemorySize, LDS_BYTES); attr = true; }
  hipLaunchKernelGGL(k_phase<PH>, dim3(256), dim3(512), LDS_BYTES, stream, p, b);
}

#ifndef DIAG
#define DIAG 0
#endif
__global__ void __launch_bounds__(256) k_diag_cmp(const bf16_t* __restrict__ A, const bf16_t* __restrict__ Bf, int* cnt) {
  __shared__ int sbad;
  const int pm = blockIdx.x >> 2, pn = blockIdx.x & 3;
  if (threadIdx.x == 0) sbad = 0;
  __syncthreads();
  int bad = 0;
  for (int i = threadIdx.x; i < 256 * 256; i += 256) {
    const int r = i >> 8, c = i & 255; const size_t o = (size_t)(pm * 256 + r) * 1024 + pn * 256 + c;
    const float a = bf2f(A[o]), b = bf2f(Bf[o]);
    if (!(fabsf(a - b) <= 0.02f)) ++bad;
  }
  if (bad) atomicAdd(&sbad, bad);
  __syncthreads();
  if (threadIdx.x == 0 && sbad) { atomicAdd(&cnt[0], 1); atomicAdd(&cnt[1], sbad); }
}
__global__ void __launch_bounds__(256) k_diag_out(float* out, const int* cnt, int which) {
  const size_t i = (size_t)blockIdx.x * 256 + threadIdx.x;
  if (i < (size_t)NTOK * 1024) out[i] = (i == 0) ? (float)cnt[which] : 0.0f;
}
extern "C" void kernel_launch(void* const* d_in, const int* in_sizes, int n_in, void* d_out, int out_size, void* d_ws, size_t ws_size, hipStream_t stream) {
  const float* x = (const float*)d_in[0]; const float* c = (const float*)d_in[1]; const float* ctx = (const float*)d_in[2]; const float* c_ctx = (const float*)d_in[3];
  const float* w_ada = (const float*)d_in[4]; const float* b_ada = (const float*)d_in[5]; const float* w_in = (const float*)d_in[6];
  const float* lbf_in = (const float*)d_in[7]; const float* lbb_in = (const float*)d_in[8]; const float* hg_norm_g = (const float*)d_in[9]; const float* rpb = (const float*)d_in[10];
  const float* w_a = (const float*)d_in[11]; const float* w_b = (const float*)d_in[12]; const float* w_out = (const float*)d_in[13];
  const float* ln1_g = (const float*)d_in[14]; const float* ln1_b = (const float*)d_in[15]; const float* w_router = (const float*)d_in[16]; const float* rbias = (const float*)d_in[17];
  const float* weg = (const float*)d_in[18]; const float* weu = (const float*)d_in[19]; const float* wed = (const float*)d_in[20];
  const float* wsg = (const float*)d_in[21]; const float* wsu = (const float*)d_in[22]; const float* wsd = (const float*)d_in[23];
  const float* ln2_g = (const float*)d_in[24]; const float* ln2_b = (const float*)d_in[25];
  char* ws = (char*)d_ws; float* out = (float*)d_out;
  float* MOD = (float*)(ws + OFF_MOD); float* LBF = (float*)(ws + OFF_LBF); float* LBB = (float*)(ws + OFF_LBB); float* ROPE = (float*)(ws + OFF_ROPE); int* CNT = (int*)(ws + OFF_CNT);
  int* TOPE = (int*)(ws + OFF_TOPE); float* TOPW = (float*)(ws + OFF_TOPW);
  bf16_t* WIN = (bf16_t*)(ws + OFF_WIN); bf16_t* WA = (bf16_t*)(ws + OFF_WA); bf16_t* WB = (bf16_t*)(ws + OFF_WB); bf16_t* WOUT = (bf16_t*)(ws + OFF_WOUT);
  bf16_t* H = (bf16_t*)(ws + OFF_H);
  bf16_t* Q = (bf16_t*)(ws + OFF_Q); f16_t* LF = (f16_t*)(ws + OFF_LF); f16_t* LB = (f16_t*)(ws + OFF_LB); bf16_t* I = (bf16_t*)(ws + OFF_I); bf16_t* OG = (bf16_t*)(ws + OFF_OG);
  bf16_t* QR = (bf16_t*)(ws + OFF_QR); bf16_t* QN = (bf16_t*)(ws + OFF_QN); bf16_t* KN = (bf16_t*)(ws + OFF_KN); bf16_t* V = (bf16_t*)(ws + OFF_V);
  float* Of = (float*)(ws + OFF_E); float* Ob = Of + (size_t)SEQ * 1024;
  bf16_t* YH = (bf16_t*)d_out; bf16_t* YN = YH + (size_t)NTOK * 1024;
  bf16_t* GA = (bf16_t*)(ws + OFF_GA); bf16_t* GB = (bf16_t*)(ws + OFF_GB); float* T1 = (float*)(ws + OFF_T1); bf16_t* T = (bf16_t*)(ws + OFF_T);
  bf16_t* WGU = (bf16_t*)(ws + OFF_WGU); bf16_t* WD = (bf16_t*)(ws + OFF_WD); bf16_t* H2 = (bf16_t*)(ws + OFF_H2); bf16_t* Y2 = (bf16_t*)(ws + OFF_Y2);

  MP mp{}; for (int i = 0; i < 26; ++i) mp.in[i] = (const float*)d_in[i]; mp.out = out; mp.ws = (unsigned char*)d_ws;
  k_prep_small<<<24, 256, 0, stream>>>(c, c_ctx, w_ada, b_ada, lbf_in, lbb_in, MOD, LBF, LBB, ROPE, CNT);
  k_transpose<<<2048, 256, 0, stream>>>(w_in, WIN, 1024, INW);
  k_transpose<<<1024, 256, 0, stream>>>(w_a, WA, 1024, 1024);
  k_transpose<<<1024, 256, 0, stream>>>(w_b, WB, 1024, 1024);
  k_transpose<<<1024, 256, 0, stream>>>(w_out, WOUT, 1024, 1024);
  k_ln_mod<<<2048, 256, 0, stream>>>(x, ctx, MOD, H);
  for (int b = 0; b < NB; ++b) {
#if FAST_S2
    launch_phase<2>(mp, b, stream);
#else
    { EpiS2 e{Q, I, OG, QR, QN, KN, V, LF, LB, LBF, LBB, ROPE, 0, 0};
    k_gemm_naive<EpiS2><<<dim3(8192 / 64, SEQ / 64), 256, 0, stream>>>(H + (size_t)b * SEQ * 1024, WIN, SEQ, 8192, 1024, e);
    e.row_off = SEQ; e.is_ctx = 1;
    k_gemm_naive<EpiS2><<<dim3(8192 / 64, CTX / 64), 256, 0, stream>>>(H + (size_t)(NTOK + b * CTX) * 1024, WIN, CTX, 8192, 1024, e); }
#endif
#ifndef FAST_HG
#define FAST_HG 1
#endif
    if (FAST_HG) { launch_phase<4>(mp, b, stream); launch_phase<5>(mp, b, stream); launch_phase<10>(mp, b, stream); }
    else {
    k_hg_naive<<<dim3(8, 2), 128, 0, stream>>>(Q, LF, LB, I, Of, Ob);
    k_hg_readout<<<2048, 256, 0, stream>>>(Of, Ob, OG, hg_norm_g, YH + (size_t)b * SEQ * 1024); }
#ifndef FAST_NA
#define FAST_NA 1
#endif
    if (FAST_NA) launch_phase<3>(mp, b, stream);
    else k_na_naive<<<16 * SEQ / 256, 256, 0, stream>>>(QR, QN, KN, V, rpb, YN + (size_t)b * SEQ * 1024);
  }
  k_conv_gu<<<4096, 256, 0, stream>>>(weg, weu, wsg, wsu, WGU);
  k_conv_d<<<4096, 256, 0, stream>>>(wed, wsd, WD);
#if DIAG
  k_gemm_naive<EpiSigmoid><<<dim3(16, NTOK / 64), 256, 0, stream>>>(H, WIN + (size_t)8192 * 1024, NTOK, 1024, 1024, EpiSigmoid{GA});
  launch_phase<6>(mp, 2, stream);
  k_diag_cmp<<<256, 256, 0, stream>>>(GA, GB, CNT);
  k_diag_out<<<NTOK * 1024 / 256, 256, 0, stream>>>(out, CNT, 1);
  return;
#endif
#ifndef FAST_MASK
#define FAST_MASK 15
#endif
  if (FAST_MASK & 1) launch_phase<6>(mp, 0, stream);
  else { k_gemm_naive<EpiSigmoid><<<dim3(16, NTOK / 64), 256, 0, stream>>>(H, WIN + (size_t)8192 * 1024, NTOK, 1024, 1024, EpiSigmoid{GA});
         k_gemm_naive<EpiSigmoid><<<dim3(16, NTOK / 64), 256, 0, stream>>>(H, WIN + (size_t)9216 * 1024, NTOK, 1024, 1024, EpiSigmoid{GB}); }
  if (FAST_MASK & 2) launch_phase<7>(mp, 0, stream); else k_gemm_naive<EpiT1><<<dim3(16, NTOK / 64), 256, 0, stream>>>(YH, WA, NTOK, 1024, 1024, EpiT1{GA, T1});
  if (FAST_MASK & 4) launch_phase<8>(mp, 0, stream); else k_gemm_naive<EpiT2><<<dim3(16, NTOK / 64), 256, 0, stream>>>(YN, WB, NTOK, 1024, 1024, EpiT2{GB, T1, T});
  if (FAST_MASK & 8) launch_phase<9>(mp, 0, stream); else k_gemm_naive<EpiR1><<<dim3(16, NTOK / 64), 256, 0, stream>>>(T, WOUT, NTOK, 1024, 1024, EpiR1{x, MOD, out});
  k_ln1_router<<<2048, 256, 0, stream>>>(out, ln1_g, ln1_b, MOD, w_router, rbias, H2, TOPE, TOPW, CNT, (int*)(ws + OFF_TOPP), (int*)(ws + OFF_LIST), (float*)(ws + OFF_LISTW));
#ifndef FAST_MOE
#define FAST_MOE 1
#endif
  if (FAST_MOE) {
    launch_phase<11>(mp, 0, stream); launch_phase<12>(mp, 0, stream); launch_phase<13>(mp, 0, stream); launch_phase<14>(mp, 0, stream); launch_phase<15>(mp, 0, stream);
  } else {
    k_moe_naive<<<NTOK, 256, 0, stream>>>(H2, WGU, WD, TOPE, TOPW, Y2);
    k_final<<<2048, 256, 0, stream>>>(out, Y2, MOD, ln2_g, ln2_b);
  }
}
```
